# Optimizing an MI355X kernel written in HIP

```python
import jax, jax.numpy as jnp
from jax import lax
import numpy as np

D_MODEL = 1024
BATCH = 2
SEQ = 8192
DEPTH = 2
DEC_BATCH = 32
DEC_SEQ = 16
PAST_LEN = 1024

CHUNK = 64
EPS = 1e-6
Q_BLOCK = 128
MLA_HEADS = 6
MLA_Q_RANK = 256
MLA_KV_RANK = 128
MLA_NOPE = 64
MLA_ROPE = 32
MLA_V = 64
ROPE_BASE = 10000.0
GLA_HEADS = 4
GLA_DK = 64
GLA_DV = 64
GLA_GATE_RANK = 16
GLA_GATE_NORM = 16.0
CA_HEADS = 6
CA_DIM = 64
CA_BAND = 8
REL_CLIP = 128
D_FF = 4 * D_MODEL

MLA_W = MLA_HEADS * MLA_V
GLA_W = GLA_HEADS * GLA_DV
CA_W = CA_HEADS * CA_DIM
IN_SPLITS = (MLA_Q_RANK, MLA_KV_RANK, MLA_ROPE,
             GLA_HEADS * GLA_DK, GLA_HEADS * GLA_DK, GLA_W, GLA_GATE_RANK, GLA_W,
             CA_W, CA_W, CA_W)
D_IN = sum(IN_SPLITS)

kernel_name = "hybrid_streaming_mla_gla_chunkband_step"

f32 = jnp.float32


def _rmsnorm(x, g):
    x32 = x.astype(f32)
    y = x32 * lax.rsqrt(jnp.mean(x32 * x32, axis=-1, keepdims=True) + EPS)
    return (y * g.astype(f32)).astype(x.dtype)


def _rope(x, pos):
    half = x.shape[-1] // 2
    inv = jnp.power(ROPE_BASE, -jnp.arange(half, dtype=f32) / half)
    ang = pos.astype(f32)[:, None] * inv[None, :]
    ang = ang.reshape((1, ang.shape[0]) + (1,) * (x.ndim - 3) + (half,))
    cos, sin = jnp.cos(ang), jnp.sin(ang)
    x1, x2 = x[..., :half].astype(f32), x[..., half:].astype(f32)
    return jnp.concatenate([x1 * cos - x2 * sin, x2 * cos + x1 * sin], axis=-1).astype(x.dtype)


def _project(h, pos, w_in, q_norm, w_qup, kv_norm, w_gate2, gate_bias):
    B, L, _ = h.shape
    z = h @ w_in
    offs = np.cumsum(IN_SPLITS)[:-1].tolist()
    q_lat, ckv, kr, gq, gk, gv, g_lr, g_out, cq, ck, cv = jnp.split(z, offs, axis=-1)
    q = (_rmsnorm(q_lat, q_norm) @ w_qup).reshape(B, L, MLA_HEADS, MLA_NOPE + MLA_ROPE)
    q = jnp.concatenate([q[..., :MLA_NOPE], _rope(q[..., MLA_NOPE:], pos)], axis=-1)
    ckv = _rmsnorm(ckv, kv_norm)
    kr = _rope(kr, pos)
    heads = lambda t, d: t.reshape(B, L, GLA_HEADS, d).transpose(0, 2, 1, 3).astype(f32)
    gq = heads(gq, GLA_DK) * (GLA_DK ** -0.5)
    gk = heads(gk, GLA_DK)
    gv = heads(gv, GLA_DV)
    loga = jax.nn.log_sigmoid((g_lr @ w_gate2 + gate_bias).astype(f32)) / GLA_GATE_NORM
    loga = heads(loga, GLA_DK)
    cq = cq.reshape(B, L, CA_HEADS, CA_DIM)
    ck = ck.reshape(B, L, CA_HEADS, CA_DIM)
    cv = cv.reshape(B, L, CA_HEADS, CA_DIM)
    return q, ckv, kr, gq, gk, gv, loga, g_out, cq, ck, cv


def _mla_kv(ckv, kr, w_kvup):
    B, T, _ = ckv.shape
    kv = (ckv @ w_kvup).reshape(B, T, MLA_HEADS, MLA_NOPE + MLA_V)
    k = jnp.concatenate([kv[..., :MLA_NOPE],
                         jnp.broadcast_to(kr[:, :, None, :], (B, T, MLA_HEADS, MLA_ROPE))], axis=-1)
    return k, kv[..., MLA_NOPE:]


def _mla_prompt(q, k, v):
    B, S, H, E = q.shape
    nb = S // Q_BLOCK
    scale = E ** -0.5
    qb = q.reshape(B, nb, Q_BLOCK, H, E).transpose(1, 0, 2, 3, 4)
    key_chunk = jnp.arange(S) // CHUNK

    def one(args):
        qblk, bi = args
        s = jnp.einsum('bqhe,bkhe->bhqk', qblk, k).astype(f32) * scale
        q_chunk = (bi * Q_BLOCK + jnp.arange(Q_BLOCK)) // CHUNK
        s = jnp.where((key_chunk[None, :] <= q_chunk[:, None])[None, None], s, -jnp.inf)
        p = jax.nn.softmax(s, axis=-1).astype(v.dtype)
        return jnp.einsum('bhqk,bkhd->bqhd', p, v)

    o = lax.map(one, (qb, jnp.arange(nb)))
    return o.transpose(1, 0, 2, 3, 4).reshape(B, S, H * MLA_V)


def _mla_sample(q, k, v):
    B, L, H, E = q.shape
    s = jnp.einsum('bqhe,bkhe->bhqk', q, k).astype(f32) * (E ** -0.5)
    p = jax.nn.softmax(s, axis=-1).astype(v.dtype)
    return jnp.einsum('bhqk,bkhd->bqhd', p, v).reshape(B, L, H * MLA_V)


def _gla_block(S0, q, k, v, loga):
    L = q.shape[2]
    b = jnp.cumsum(loga, axis=2)
    causal = jnp.tril(jnp.ones((L, L), dtype=bool))
    diff = b[:, :, :, None, :] - b[:, :, None, :, :]
    decay = jnp.exp(jnp.where(causal[None, None, :, :, None], diff, -jnp.inf))
    A = jnp.einsum('bhid,bhjd,bhijd->bhij', q, k, decay)
    o = jnp.einsum('bhij,bhjv->bhiv', A, v) + jnp.einsum('bhid,bhdv->bhiv', q * jnp.exp(b), S0)
    b_last = b[:, :, -1:, :]
    S1 = jnp.exp(b_last[:, :, 0, :])[..., None] * S0 \
        + jnp.einsum('bhjd,bhjv->bhdv', k * jnp.exp(b_last - b), v)
    return S1, o


def _gla_prompt(q, k, v, loga):
    B, H, S, _ = q.shape
    n = S // CHUNK
    to_chunks = lambda t: t.reshape(B, H, n, CHUNK, t.shape[-1]).transpose(2, 0, 1, 3, 4)
    S0 = jnp.zeros((B, H, GLA_DK, GLA_DV), f32)
    S_fin, o = lax.scan(lambda s, xs: _gla_block(s, *xs), S0,
                        (to_chunks(q), to_chunks(k), to_chunks(v), to_chunks(loga)))
    return o.transpose(1, 2, 0, 3, 4).reshape(B, H, S, GLA_DV), S_fin


def _rel_bias(rel, table):
    idx = jnp.clip(rel, -REL_CLIP, REL_CLIP) + REL_CLIP
    return jnp.take(table, idx, axis=0).transpose(2, 0, 1).astype(f32)


def _ca_prompt(q, k, v, table):
    B, S, H, E = q.shape
    n = S // CHUNK
    W = (CA_BAND + 1) * CHUNK
    pad = ((0, 0), (CA_BAND * CHUNK, 0), (0, 0), (0, 0))
    idx = jnp.arange(n)[:, None] * CHUNK + jnp.arange(W)[None, :]
    kb = jnp.pad(k, pad)[:, idx]
    vb = jnp.pad(v, pad)[:, idx]
    qc = q.reshape(B, n, CHUNK, H, E)
    s = jnp.einsum('bnqhe,bnkhe->bnhqk', qc, kb).astype(f32) * (E ** -0.5)
    rel = (jnp.arange(W) - CA_BAND * CHUNK)[None, :] - jnp.arange(CHUNK)[:, None]
    s = s + _rel_bias(rel, table)[None, None]
    key_chunk = jnp.arange(n)[:, None] - CA_BAND + (jnp.arange(W) // CHUNK)[None, :]
    s = jnp.where((key_chunk >= 0)[None, :, None, None, :], s, -jnp.inf)
    p = jax.nn.softmax(s, axis=-1).astype(v.dtype)
    return jnp.einsum('bnhqk,bnkhe->bnqhe', p, vb).reshape(B, S, H * E)


def _ca_sample(q, k_new, v_new, cache_k, cache_v, table):
    B, L, H, E = q.shape
    Wp = cache_k.shape[1]
    k = jnp.concatenate([cache_k, k_new], axis=1)
    v = jnp.concatenate([cache_v, v_new], axis=1)
    s = jnp.einsum('bqhe,bkhe->bhqk', q, k).astype(f32) * (E ** -0.5)
    rel = jnp.arange(-Wp, L)[None, :] - jnp.arange(L)[:, None]
    s = s + _rel_bias(rel, table)[None]
    p = jax.nn.softmax(s, axis=-1).astype(v.dtype)
    return jnp.einsum('bhqk,bkhe->bqhe', p, v).reshape(B, L, H * E)


def _merge(o_mla, o_gla, g_out, o_ca, gla_norm, w_out):
    B, L, _ = o_mla.shape
    og = _rmsnorm(o_gla.transpose(0, 2, 1, 3), gla_norm.reshape(GLA_HEADS, GLA_DV)).reshape(B, L, GLA_W)
    og = og.astype(o_mla.dtype) * jax.nn.silu(g_out)
    return jnp.concatenate([o_mla, og, o_ca], axis=-1) @ w_out


def _mlp(h, w_up, w_down):
    return jnp.square(jax.nn.relu(h @ w_up)) @ w_down


def setup_inputs(seed: int = 0) -> dict:
    key = jax.random.key(seed)
    ks = jax.random.split(key, 24)
    nrm = lambda k, shape, scale: jax.random.normal(k, shape, f32) * scale
    gain = lambda k, shape: 1.0 + 0.01 * jax.random.normal(k, shape, f32)
    ca_past = min(CA_BAND * CHUNK, PAST_LEN)
    return {
        "x_prompt": nrm(ks[0], (BATCH, SEQ, D_MODEL), 1.0),
        "x_sample": nrm(ks[1], (DEC_BATCH, DEC_SEQ, D_MODEL), 1.0),
        "cache_mla_ckv": nrm(ks[2], (DEPTH, DEC_BATCH, PAST_LEN, MLA_KV_RANK), 1.0),
        "cache_mla_krope": nrm(ks[3], (DEPTH, DEC_BATCH, PAST_LEN, MLA_ROPE), 1.0),
        "state_gla": nrm(ks[4], (DEPTH, DEC_BATCH, GLA_HEADS, GLA_DK, GLA_DV), 0.5),
        "cache_ca_k": nrm(ks[5], (DEPTH, DEC_BATCH, ca_past, CA_HEADS, CA_DIM), 1.0),
        "cache_ca_v": nrm(ks[6], (DEPTH, DEC_BATCH, ca_past, CA_HEADS, CA_DIM), 1.0),
        "norm1": gain(ks[7], (DEPTH, D_MODEL)),
        "w_in": nrm(ks[8], (DEPTH, D_MODEL, D_IN), D_MODEL ** -0.5),
        "mla_q_norm": gain(ks[9], (DEPTH, MLA_Q_RANK)),
        "mla_w_qup": nrm(ks[10], (DEPTH, MLA_Q_RANK, MLA_HEADS * (MLA_NOPE + MLA_ROPE)), MLA_Q_RANK ** -0.5),
        "mla_kv_norm": gain(ks[11], (DEPTH, MLA_KV_RANK)),
        "mla_w_kvup": nrm(ks[12], (DEPTH, MLA_KV_RANK, MLA_HEADS * (MLA_NOPE + MLA_V)), MLA_KV_RANK ** -0.5),
        "gla_w_gate2": nrm(ks[13], (DEPTH, GLA_GATE_RANK, GLA_HEADS * GLA_DK), GLA_GATE_RANK ** -0.5),
        "gla_gate_bias": nrm(ks[14], (DEPTH, GLA_HEADS * GLA_DK), 0.1),
        "gla_out_norm": gain(ks[15], (DEPTH, GLA_W)),
        "ca_rel_bias": nrm(ks[16], (DEPTH, 2 * REL_CLIP + 1, CA_HEADS), 0.1),
        "w_out": nrm(ks[17], (DEPTH, D_MODEL, D_MODEL), D_MODEL ** -0.5),
        "norm2": gain(ks[18], (DEPTH, D_MODEL)),
        "w_up": nrm(ks[19], (DEPTH, D_MODEL, D_FF), D_MODEL ** -0.5),
        "w_down": nrm(ks[20], (DEPTH, D_FF, D_MODEL), D_FF ** -0.5),
        "final_norm": gain(ks[21], (D_MODEL,)),
    }


def reference(x_prompt, x_sample, cache_mla_ckv, cache_mla_krope, state_gla, cache_ca_k, cache_ca_v,
              norm1, w_in, mla_q_norm, mla_w_qup, mla_kv_norm, mla_w_kvup, gla_w_gate2, gla_gate_bias,
              gla_out_norm, ca_rel_bias, w_out, norm2, w_up, w_down, final_norm):
    n_seq = x_prompt.shape[1]
    n_new = x_sample.shape[1]
    past_len = cache_mla_ckv.shape[2]
    pos_p = jnp.arange(n_seq)
    pos_s = past_len + jnp.arange(n_new)
    band_rows = min(CA_BAND * CHUNK, n_seq)
    xp, xs = x_prompt, x_sample
    p_ckv, p_kr, p_gla, p_ck, p_cv = [], [], [], [], []
    s_ckv, s_kr, s_gla, s_ck, s_cv = [], [], [], [], []
    for l in range(DEPTH):
        proj_w = (w_in[l], mla_q_norm[l], mla_w_qup[l], mla_kv_norm[l], gla_w_gate2[l], gla_gate_bias[l])
        q, ckv, kr, gq, gk, gv, loga, g_out, cq, ck, cv = _project(_rmsnorm(xp, norm1[l]), pos_p, *proj_w)
        k_m, v_m = _mla_kv(ckv, kr, mla_w_kvup[l])
        o_mla = _mla_prompt(q, k_m, v_m)
        o_gla, S_fin = _gla_prompt(gq, gk, gv, loga)
        o_ca = _ca_prompt(cq, ck, cv, ca_rel_bias[l])
        xp = xp + _merge(o_mla, o_gla, g_out, o_ca, gla_out_norm[l], w_out[l])
        xp = xp + _mlp(_rmsnorm(xp, norm2[l]), w_up[l], w_down[l])
        p_ckv.append(ckv)
        p_kr.append(kr)
        p_gla.append(S_fin.astype(xp.dtype))
        p_ck.append(ck[:, n_seq - band_rows:])
        p_cv.append(cv[:, n_seq - band_rows:])
        q, ckv, kr, gq, gk, gv, loga, g_out, cq, ck, cv = _project(_rmsnorm(xs, norm1[l]), pos_s, *proj_w)
        k_m, v_m = _mla_kv(jnp.concatenate([cache_mla_ckv[l], ckv], axis=1),
                           jnp.concatenate([cache_mla_krope[l], kr], axis=1), mla_w_kvup[l])
        o_mla = _mla_sample(q, k_m, v_m)
        S_new, o_gla = _gla_block(state_gla[l].astype(f32), gq, gk, gv, loga)
        o_ca = _ca_sample(cq, ck, cv, cache_ca_k[l], cache_ca_v[l], ca_rel_bias[l])
        xs = xs + _merge(o_mla, o_gla, g_out, o_ca, gla_out_norm[l], w_out[l])
        xs = xs + _mlp(_rmsnorm(xs, norm2[l]), w_up[l], w_down[l])
        s_ckv.append(ckv)
        s_kr.append(kr)
        s_gla.append(S_new.astype(state_gla.dtype))
        s_ck.append(ck)
        s_cv.append(cv)
    y_prompt = _rmsnorm(xp, final_norm)
    y_sample = _rmsnorm(xs, final_norm)
    return (y_prompt, y_sample,
            jnp.stack(p_ckv), jnp.stack(p_kr), jnp.stack(p_gla), jnp.stack(p_ck), jnp.stack(p_cv),
            jnp.stack(s_ckv), jnp.stack(s_kr), jnp.stack(s_gla), jnp.stack(s_ck), jnp.stack(s_cv))
```

```cpp
#include <hip/hip_runtime.h>
#include <hip/hip_cooperative_groups.h>
#include <cstdio>
#include <cstdint>
namespace cg = cooperative_groups;
namespace pg8 {
#define PG8_LAS __attribute__((address_space(3)))
typedef unsigned short bf16_t;
typedef short bf16x8 __attribute__((ext_vector_type(8)));
typedef float f32x4 __attribute__((ext_vector_type(4)));
typedef unsigned u32x4 __attribute__((ext_vector_type(4)));
constexpr int BM = 256, BK = 64, HALF = 128, HTB = HALF * BK * 2  , STAGE_BYTES = 8 * HTB, NXCD = 8, WGM = 8;

__host__ __device__ __forceinline__ int lds_byte(int r, int c) { const int st = (r >> 4) * 2 + (c >> 5), rr = r & 15, cc = c & 31, ob = rr * 64 + cc * 2; return st * 1024 + (ob ^ (((ob >> 9) & 1) << 5)); }
__host__ __device__ __forceinline__ void stage_rc(int b, int& R, int& C) { const int st = b / 1024, sb = b % 1024, swz = sb ^ (((sb >> 9) & 1) << 5); R = (st >> 1) * 16 + swz / 64; C = (st & 1) * 32 + (swz % 64) / 2; }
__host__ __device__ __forceinline__ int perm32(int rho) { const int n = rho >> 4, i = rho & 15; return 8 * (i >> 2) + 4 * n + (i & 3); }

struct Unit { int pm, pn, ks; };
struct Gemm { const bf16_t* A; const bf16_t* Bt; int M, N, K, ld; };

struct StaticOrder {
    int nM, nN, nwg, G, c;
    __host__ __device__ void init(int M, int N, int G_, int c_) { nM = M / BM; nN = N / BM; nwg = nM * nN; G = G_; c = c_; }
    __host__ __device__ bool next(int i, Unit& u) const {
        const long L = (long)i * G + c; if (L >= nwg) return false;
        int wgid = (int)L; { const int q = nwg / NXCD, r = nwg % NXCD, xcd = wgid % NXCD, off = wgid / NXCD; wgid = (xcd < r ? xcd * (q + 1) : r * (q + 1) + (xcd - r) * q) + off; }
        const int nig = WGM * nN, gid = wgid / nig, fm = gid * WGM, gsz = (nM - fm) < WGM ? (nM - fm) : WGM;
        u.pm = fm + ((wgid % nig) % gsz); u.pn = (wgid % nig) / gsz; u.ks = 0; return true;
    }
    __device__ __forceinline__ void a_ready(const Unit&) const {}
    __device__ __forceinline__ void done(const Unit&) const {}
};

struct SplitOrder {
    int nM, nN, nS, G, c;
    __host__ __device__ void init(int M, int N, int nS_, int G_, int c_) { nM = M / BM; nN = N / BM; nS = nS_; G = G_; c = c_; }
    __host__ __device__ bool next(int i, Unit& u) const {
        const long L = (long)i * G + c; if (L >= (long)nM * nN * nS) return false;
        const int r = (int)L; u.ks = r % nS; const int t = r / nS; u.pn = t % nN; u.pm = t / nN; return true;
    }
    __device__ __forceinline__ void a_ready(const Unit&) const {}
    __device__ __forceinline__ void done(const Unit&) const {}
};
typedef float f32x2_t __attribute__((ext_vector_type(2))); typedef __bf16 bf16x2_t __attribute__((ext_vector_type(2)));
__device__ __forceinline__ unsigned cvt_pk_bf16(float lo, float hi) { f32x2_t v = {lo, hi}; bf16x2_t b = __builtin_convertvector(v, bf16x2_t); return __builtin_bit_cast(unsigned, b); }
template <int ACT  > struct EpiStore {
    static constexpr bool PERM = true, AFTER_DRAIN = false;
    bf16_t* O; int ldc; int ncols; int nrows;
    __device__ __forceinline__ void operator()(const f32x4 (&acc)[2][2][4][2], const Unit& u, int wr, int wc, int fr, int fq) const {
        const int row0 = u.pm * BM + wr * 64 + fr; const int col0 = u.pn * BM + wc * 32 + 8 * fq;
#pragma unroll
        for (int ai = 0; ai < 2; ++ai)
#pragma unroll
            for (int m = 0; m < 4; ++m) { const int row = row0 + ai * HALF + m * 16; if (row >= nrows) continue;
                bf16_t* rowp = O + (size_t)row * ldc;
#pragma unroll
                for (int bj = 0; bj < 2; ++bj) { const int col = col0 + bj * HALF; if (col >= ncols) continue;
                    f32x4 v0 = acc[ai][bj][m][0], v1 = acc[ai][bj][m][1];
                    if (ACT == 1) {
#pragma unroll
                        for (int e = 0; e < 4; ++e) { float a = v0[e] > 0.f ? v0[e] : 0.f; v0[e] = a * a; float b = v1[e] > 0.f ? v1[e] : 0.f; v1[e] = b * b; } }
                    u32x4 w; w.x = cvt_pk_bf16(v0[0], v0[1]); w.y = cvt_pk_bf16(v0[2], v0[3]); w.z = cvt_pk_bf16(v1[0], v1[1]); w.w = cvt_pk_bf16(v1[2], v1[3]);
                    *(u32x4*)(rowp + col) = w; } }
    }
};
struct EpiResidual {
    static constexpr bool PERM = true, AFTER_DRAIN = false;
    const float* B; float* X; int ldc;
    __device__ __forceinline__ void operator()(const f32x4 (&acc)[2][2][4][2], const Unit& u, int wr, int wc, int fr, int fq) const {
        const int row0 = u.pm * BM + wr * 64 + fr; const int col0 = u.pn * BM + wc * 32 + 8 * fq;
#pragma unroll
        for (int ai = 0; ai < 2; ++ai)
#pragma unroll
            for (int m = 0; m < 4; ++m) { const size_t off = (size_t)(row0 + ai * HALF + m * 16) * ldc + col0; const float* bp = B + off; float* rowp = X + off;
#pragma unroll
                for (int bj = 0; bj < 2; ++bj) {
                    f32x4 x0 = *(const f32x4*)(bp + bj * HALF), x1 = *(const f32x4*)(bp + bj * HALF + 4);
                    x0 = x0 + acc[ai][bj][m][0]; x1 = x1 + acc[ai][bj][m][1];
                    *(f32x4*)(rowp + bj * HALF) = x0; *(f32x4*)(rowp + bj * HALF + 4) = x1; }
                asm volatile("" ::: "memory"); }
    }
};
struct EpiPartial {
    static constexpr bool PERM = true, AFTER_DRAIN = false;
    float* P; int ldc; size_t sstride;
    __device__ __forceinline__ void operator()(const f32x4 (&acc)[2][2][4][2], const Unit& u, int wr, int wc, int fr, int fq) const {
        const int row0 = u.pm * BM + wr * 64 + fr; const int col0 = u.pn * BM + wc * 32 + 8 * fq;
        float* base = P + (size_t)u.ks * sstride;
#pragma unroll
        for (int ai = 0; ai < 2; ++ai)
#pragma unroll
            for (int m = 0; m < 4; ++m) { float* rowp = base + (size_t)(row0 + ai * HALF + m * 16) * ldc + col0;
#pragma unroll
                for (int bj = 0; bj < 2; ++bj) { *(f32x4*)(rowp + bj * HALF) = acc[ai][bj][m][0]; *(f32x4*)(rowp + bj * HALF + 4) = acc[ai][bj][m][1]; } }
    }
};
template <class Epi, class Sched, bool ALIGN_EPI = false, bool SP2 = false>
__device__ __forceinline__ void gemm_phase(PG8_LAS unsigned char* lds, const Gemm g, const Sched& S, const Epi& E) {
    int tid_o = threadIdx.x; asm volatile("" : "+v"(tid_o)); const int tid = tid_o, wid = __builtin_amdgcn_readfirstlane(tid >> 6), lane = tid & 63, wr = wid >> 2, wc = wid & 3, fr = lane & 15, fq = lane >> 4;
    const int K = g.K, nt = K / BK, LD = g.ld ? g.ld : g.K;
    unsigned voffA[2], voffB[2];
#pragma unroll
    for (int i = 0; i < 2; ++i) { int R, C; stage_rc(tid * 16 + i * 8192, R, C); const int Rb = Epi::PERM ? ((R & ~31) + perm32(R & 31)) : R;
        voffA[i] = (unsigned)(R * LD + C) * 2u; voffB[i] = (unsigned)(Rb * LD + C) * 2u; }
    const size_t kstep = (size_t)(BK * 2);
    const size_t hstep = (size_t)HALF * LD * 2;
    const size_t tstep = 2 * hstep;
    const unsigned ldsw = (unsigned)wid * 1024u;
    const int aoff = lds_byte(wr * 64 + fr, fq * 8), boff = lds_byte(wc * 32 + fr, fq * 8);
#define PG8_SA(b, h) (((b) * 2 + (h)) * HTB)
#define PG8_SB(b, h) ((4 + (b) * 2 + (h)) * HTB)
#define PG8_STAGE(bufoff, gbase, voff) do { _Pragma("unroll") for (int _i = 0; _i < 2; ++_i) \
        __builtin_amdgcn_global_load_lds((const unsigned*)((const char*)(gbase) + (voff)[_i]), (PG8_LAS unsigned*)(lds + (bufoff) + ldsw + _i * 8192), 16, 0, 0); } while (0)
#define PG8_LDA(dst, b, h) do { _Pragma("unroll") for (int m = 0; m < 4; ++m) _Pragma("unroll") for (int k = 0; k < 2; ++k) dst[m][k] = *(const PG8_LAS bf16x8*)(lds + PG8_SA(b, h) + aoff + m * 2048 + k * 1024); } while (0)
#define PG8_LDB(dst, b, h) do { _Pragma("unroll") for (int n = 0; n < 2; ++n) _Pragma("unroll") for (int k = 0; k < 2; ++k) dst[n][k] = *(const PG8_LAS bf16x8*)(lds + PG8_SB(b, h) + boff + n * 2048 + k * 1024); } while (0)
#define PG8_MMA(ai, bj, At, Bt) do { __builtin_amdgcn_s_setprio(1); _Pragma("unroll") for (int m = 0; m < 4; ++m) _Pragma("unroll") for (int n = 0; n < 2; ++n) _Pragma("unroll") for (int k = 0; k < 2; ++k) \
        acc[ai][bj][m][n] = __builtin_amdgcn_mfma_f32_16x16x32_bf16(Bt[n][k], At[m][k], acc[ai][bj][m][n], 0, 0, 0); __builtin_amdgcn_s_setprio(0); } while (0)
#define PG8_WAIT_V(n) asm volatile("s_waitcnt vmcnt(" #n ")" ::: "memory")
#define PG8_WAIT_L(n) asm volatile("s_waitcnt lgkmcnt(" #n ")" ::: "memory")
#define PG8_BAR __builtin_amdgcn_s_barrier()
#define PG8_SCHED __builtin_amdgcn_sched_barrier(0)
    Unit cur, nxt; int ui = 0;
    if (!S.next(0, cur)) return;
    f32x4 acc[2][2][4][2];
#pragma unroll
    for (int a = 0; a < 2; ++a)
#pragma unroll
        for (int b = 0; b < 2; ++b)
#pragma unroll
            for (int m = 0; m < 4; ++m)
#pragma unroll
                for (int n = 0; n < 2; ++n) acc[a][b][m][n] = (f32x4){0.f, 0.f, 0.f, 0.f};
    bf16x8 At[4][2], B0[2][2], B1[2][2];
    const char* cA = (const char*)g.A + (size_t)cur.pm * tstep + (size_t)cur.ks * K * 2; const char* cB = (const char*)g.Bt + (size_t)cur.pn * tstep + (size_t)cur.ks * K * 2;
    S.a_ready(cur);
    if constexpr (SP2) {
        PG8_STAGE(PG8_SB(0, 0), cB, voffB); PG8_STAGE(PG8_SB(0, 1), cB + hstep, voffB); PG8_STAGE(PG8_SA(0, 0), cA, voffA); PG8_STAGE(PG8_SA(0, 1), cA + hstep, voffA);
        if (wr == 1) PG8_BAR;
        PG8_WAIT_V(2); PG8_BAR;
        PG8_STAGE(PG8_SB(1, 0), cB + kstep, voffB); PG8_STAGE(PG8_SA(1, 0), cA + kstep, voffA); PG8_STAGE(PG8_SB(1, 1), cB + hstep + kstep, voffB);
        PG8_WAIT_V(6); PG8_BAR;
    } else {
        PG8_STAGE(PG8_SB(0, 0), cB, voffB); PG8_STAGE(PG8_SA(0, 0), cA, voffA); PG8_STAGE(PG8_SB(0, 1), cB + hstep, voffB); PG8_STAGE(PG8_SA(0, 1), cA + hstep, voffA);
        if (wr == 1) PG8_BAR;
        PG8_WAIT_V(4); PG8_BAR;
        PG8_STAGE(PG8_SB(1, 0), cB + kstep, voffB); PG8_STAGE(PG8_SA(1, 0), cA + kstep, voffA); PG8_STAGE(PG8_SB(1, 1), cB + hstep + kstep, voffB);
        PG8_WAIT_V(6); PG8_BAR;
    }
    for (;;) {
        const bool has_next = S.next(ui + 1, nxt);
        const char* nA = has_next ? (const char*)g.A + (size_t)nxt.pm * tstep + (size_t)nxt.ks * K * 2 : cA; const char* nB = has_next ? (const char*)g.Bt + (size_t)nxt.pn * tstep + (size_t)nxt.ks * K * 2 : cB;
        for (int t = 0; t < nt; t += 2) {
            const bool last = (t == nt - 2);
            const char* a1 = cA + (size_t)(t + 1) * kstep;
            const char* a2 = last ? nA : cA + (size_t)(t + 2) * kstep; const char* b2 = last ? nB : cB + (size_t)(t + 2) * kstep;
            const char* a3 = a2 + kstep; const char* b3 = b2 + kstep;
            if (last && has_next) S.a_ready(nxt);
            if constexpr (SP2) {
            PG8_LDB(B0, 0, 0); PG8_LDB(B1, 0, 1); PG8_SCHED; PG8_LDA(At, 0, 0); PG8_STAGE(PG8_SA(1, 1), a1 + hstep, voffA);
            PG8_WAIT_V(8); PG8_WAIT_L(0); PG8_BAR; PG8_MMA(0, 0, At, B0); PG8_MMA(0, 1, At, B1); PG8_BAR; PG8_SCHED;
            PG8_LDA(At, 0, 1); PG8_STAGE(PG8_SB(0, 0), b2, voffB); PG8_STAGE(PG8_SB(0, 1), b2 + hstep, voffB); PG8_STAGE(PG8_SA(0, 0), a2, voffA);
            PG8_WAIT_V(8); PG8_WAIT_L(0); PG8_BAR; PG8_MMA(1, 0, At, B0); PG8_MMA(1, 1, At, B1); PG8_BAR; PG8_SCHED;
            PG8_LDB(B0, 1, 0); PG8_LDB(B1, 1, 1); PG8_SCHED; PG8_LDA(At, 1, 0); PG8_STAGE(PG8_SA(0, 1), a2 + hstep, voffA);
            PG8_WAIT_V(8); PG8_WAIT_L(0); PG8_BAR; PG8_MMA(0, 0, At, B0); PG8_MMA(0, 1, At, B1); PG8_BAR; PG8_SCHED;
            PG8_LDA(At, 1, 1); PG8_STAGE(PG8_SB(1, 0), b3, voffB); PG8_STAGE(PG8_SB(1, 1), b3 + hstep, voffB); PG8_STAGE(PG8_SA(1, 0), a3, voffA);
            PG8_WAIT_V(8); PG8_WAIT_L(0); PG8_BAR; PG8_MMA(1, 0, At, B0); PG8_MMA(1, 1, At, B1); PG8_BAR; PG8_SCHED;
            } else {
            PG8_LDB(B0, 0, 0); PG8_SCHED; PG8_LDA(At, 0, 0); PG8_STAGE(PG8_SA(1, 1), a1 + hstep, voffA);
            PG8_WAIT_L(8); PG8_BAR; PG8_WAIT_L(0); PG8_MMA(0, 0, At, B0); PG8_BAR; PG8_SCHED;
            PG8_LDB(B1, 0, 1); PG8_STAGE(PG8_SB(0, 0), b2, voffB);
            PG8_BAR; PG8_WAIT_L(0); PG8_MMA(0, 1, At, B1); PG8_BAR;
            PG8_LDA(At, 0, 1); PG8_STAGE(PG8_SA(0, 0), a2, voffA);
            PG8_BAR; PG8_WAIT_L(0); PG8_MMA(1, 0, At, B0); PG8_BAR; PG8_SCHED;
            PG8_STAGE(PG8_SB(0, 1), b2 + hstep, voffB);
            PG8_WAIT_V(6); PG8_BAR; PG8_MMA(1, 1, At, B1); PG8_BAR;
            PG8_LDB(B0, 1, 0); PG8_SCHED; PG8_LDA(At, 1, 0); PG8_STAGE(PG8_SA(0, 1), a2 + hstep, voffA);
            PG8_WAIT_L(8); PG8_BAR; PG8_WAIT_L(0); PG8_MMA(0, 0, At, B0); PG8_BAR; PG8_SCHED;
            PG8_LDB(B1, 1, 1); PG8_STAGE(PG8_SB(1, 0), b3, voffB);
            PG8_BAR; PG8_WAIT_L(0); PG8_MMA(0, 1, At, B1); PG8_BAR;
            PG8_LDA(At, 1, 1); PG8_STAGE(PG8_SA(1, 0), a3, voffA);
            PG8_BAR; PG8_WAIT_L(0); PG8_MMA(1, 0, At, B0); PG8_BAR; PG8_SCHED;
            PG8_STAGE(PG8_SB(1, 1), b3 + hstep, voffB);
            PG8_WAIT_V(6); PG8_BAR; PG8_MMA(1, 1, At, B1); PG8_BAR;
            }
        }
        if constexpr (ALIGN_EPI) { if (wr == 0) PG8_BAR; }
        if constexpr (!Epi::AFTER_DRAIN) { E(acc, cur, wr, wc, fr, fq); S.done(cur); }
        if (!has_next) break;
#pragma unroll
        for (int a = 0; a < 2; ++a)
#pragma unroll
            for (int b = 0; b < 2; ++b)
#pragma unroll
                for (int m = 0; m < 4; ++m)
#pragma unroll
                    for (int n = 0; n < 2; ++n) acc[a][b][m][n] = (f32x4){0.f, 0.f, 0.f, 0.f};
        cur = nxt; cA = nA; cB = nB; ++ui;
        if constexpr (ALIGN_EPI) { if (wr == 1) PG8_BAR; }
    }
    PG8_WAIT_V(0);
    if constexpr (!ALIGN_EPI) { if (wr == 0) PG8_BAR; }
    PG8_BAR;
    if constexpr (Epi::AFTER_DRAIN) { E.fused(acc, cur, wr, wc, fr, fq, lds, wid, lane); S.done(cur); }
#undef PG8_SA
#undef PG8_SB
#undef PG8_STAGE
#undef PG8_LDA
#undef PG8_LDB
#undef PG8_MMA
#undef PG8_WAIT_V
#undef PG8_WAIT_L
#undef PG8_BAR
#undef PG8_SCHED
}
}

#define DI __device__ __forceinline__
#define LAS __attribute__((address_space(3)))
typedef unsigned short bf16;
typedef short bf16x8 __attribute__((ext_vector_type(8)));
typedef short s16x4 __attribute__((ext_vector_type(4)));
typedef float f32x4 __attribute__((ext_vector_type(4)));
typedef float f32x2 __attribute__((ext_vector_type(2)));
typedef float f32x16 __attribute__((ext_vector_type(16)));
typedef unsigned u32x4 __attribute__((ext_vector_type(4)));
typedef unsigned u32x2 __attribute__((ext_vector_type(2)));

constexpr int DM = 1024, SEQ = 8192, NBAT = 2, MP = NBAT * SEQ, DBAT = 32, DSEQ = 16, MS = DBAT * DSEQ, MT = MP + MS, PAST = 1024;
constexpr int RALL = MT + DBAT * PAST;
constexpr int DIN = 2608, DFF = 4096;
constexpr int C_QLAT = 0, C_CKV = 256, C_KR = 384, C_GQ = 416, C_GK = 672, C_GV = 928, C_GLR = 1184, C_GOUT = 1200, C_CQ = 1456, C_CK = 1840, C_CV = 2224;
constexpr float EPS = 1e-6f;
constexpr float LOG2E = 1.4426950408889634f;
constexpr size_t O_Y = 0;
constexpr size_t O_PCKV = (size_t)MT * DM;
constexpr size_t O_PKR = O_PCKV + (size_t)2 * NBAT * SEQ * 128;
constexpr size_t O_PGLA = O_PKR + (size_t)2 * NBAT * SEQ * 32;
constexpr size_t O_PCAK = O_PGLA + (size_t)2 * NBAT * 4 * 64 * 64;
constexpr size_t O_PCAV = O_PCAK + (size_t)2 * NBAT * 512 * 384;
constexpr size_t O_SCKV = O_PCAV + (size_t)2 * NBAT * 512 * 384;
constexpr size_t O_SKR = O_SCKV + (size_t)2 * DBAT * DSEQ * 128;
constexpr size_t O_SGLA = O_SKR + (size_t)2 * DBAT * DSEQ * 32;
constexpr size_t O_SCAK = O_SGLA + (size_t)2 * DBAT * 4 * 64 * 64;
constexpr size_t O_SCAV = O_SCAK + (size_t)2 * DBAT * DSEQ * 384;
constexpr size_t O_END = O_SCAV + (size_t)2 * DBAT * DSEQ * 384;
static_assert(O_END == 26181632, "output size");
constexpr size_t al256(size_t x) { return (x + 255) & ~(size_t)255; }
constexpr size_t WS_CTL = 0;
constexpr size_t WS_WIN = 65536;
constexpr size_t WS_WQ = WS_WIN + (size_t)2816 * 1024 * 2;
constexpr size_t WS_WK = WS_WQ + (size_t)768 * 256 * 2;
constexpr size_t WS_WV = WS_WK + (size_t)512 * 128 * 2;
constexpr size_t WS_WO = WS_WV + (size_t)512 * 128 * 2;
constexpr size_t WS_WUP = WS_WO + (size_t)1024 * 1024 * 2;
constexpr size_t WS_WDN = WS_WUP + (size_t)4096 * 1024 * 2;
constexpr size_t WS_XN = WS_WDN + (size_t)1024 * 4096 * 2;
constexpr size_t WS_QN = WS_XN + (size_t)MT * 1024 * 2;
constexpr size_t WS_CKV = WS_QN + (size_t)MT * 256 * 2;
constexpr size_t WS_KR = WS_CKV + (size_t)RALL * 128 * 2;
constexpr size_t WS_GU = WS_KR + (size_t)RALL * 32 * 2;
constexpr size_t WS_GA = WS_GU + (size_t)1024 * 4096 * 4;
constexpr size_t WS_Z = WS_GA + (size_t)1024 * 64 * 4;
constexpr size_t WS_QM = WS_Z + (size_t)MT * DIN * 2;
constexpr size_t WS_KN = WS_QM + (size_t)MT * 576 * 2;
constexpr size_t WS_VT = WS_KN + (size_t)RALL * 384 * 2;
constexpr size_t WS_END0 = WS_VT + (size_t)384 * RALL * 2;
constexpr size_t WS_H = WS_Z;
static_assert(WS_H + (size_t)MT * DFF * 2 <= WS_END0, "H overlay");
constexpr size_t WS_PART = WS_H + (size_t)MT * DFF * 2;
static_assert(WS_PART + (size_t)16 * MS * DM * 4 <= WS_END0, "partials");
constexpr size_t WS_W1OFS = WS_END0 - WS_WIN;
constexpr size_t WS_NEED = WS_END0 + (WS_XN - WS_WIN);
static_assert(WS_NEED <= 314907696ull, "ws budget");
static_assert(WS_XN % 256 == 0 && WS_Z % 256 == 0 && WS_QM % 256 == 0 && WS_KN % 256 == 0 && WS_VT % 256 == 0 && WS_CKV % 256 == 0, "align");

constexpr int LDS_BYTES = 147456;
constexpr int LDS_MISC = 131072;

struct Params { const float* in[22]; float* out; unsigned char* ws; int ph_lo, ph_hi; };
enum { I_XP = 0, I_XS, I_CCKV, I_CKR, I_SGLA, I_CCAK, I_CCAV, I_NORM1, I_WIN, I_QNORM, I_WQUP, I_KVNORM, I_WKVUP, I_WG2, I_GBIAS, I_GONORM, I_RELB, I_WOUT, I_NORM2, I_WUP, I_WDN, I_FNORM };

DI float bf2f(bf16 u) { return __uint_as_float((unsigned)u << 16); }
typedef __bf16 bf16x2_t __attribute__((ext_vector_type(2)));
DI unsigned pk2(float lo, float hi) { f32x2 v = {lo, hi}; bf16x2_t b = __builtin_convertvector(v, bf16x2_t); return __builtin_bit_cast(unsigned, b); }
DI bf16 f2bf(float f) { return (bf16)(pk2(f, 0.f) & 0xffffu); }
DI float shx(float v, int o, int lane) { return __int_as_float(__builtin_amdgcn_ds_bpermute((lane ^ o) << 2, __float_as_int(v))); }
DI float wave_sum(float v, int lane) {
#pragma unroll
    for (int o = 1; o < 64; o <<= 1) v += shx(v, o, lane);
    return v;
}
DI int crow(int i, int h2) { return (i & 3) + 8 * (i >> 2) + 4 * h2; }
#define MFMA32(a, b, c) __builtin_amdgcn_mfma_f32_32x32x16_bf16((a), (b), (c), 0, 0, 0)
DI void sincos_pos(float ang, float& s, float& c) {
    const double rev = (double)ang * 0.15915494309189535; const float f = (float)(rev - floor(rev));
    s = __builtin_amdgcn_sinf(f); c = __builtin_amdgcn_cosf(f);
}
DI float rope_inv(int i) { return exp2f(-(float)i * (13.287712379549449f / 16.0f)); }

DI void transpose_item(const float* W, int K, int N, bf16* dst, int k0, int n0, LAS float* scr, int lane) {
    const int nc = n0 + (lane & 31); const bool ok = nc < N;
    float wv[32];
#pragma unroll
    for (int i = 0; i < 32; ++i) { const int kk = 2 * i + (lane >> 5); wv[i] = ok ? W[(size_t)(k0 + kk) * N + nc] : 0.f; }
#pragma unroll
    for (int i = 0; i < 32; ++i) { const int kk = 2 * i + (lane >> 5); scr[kk * 33 + (lane & 31)] = wv[i]; }
    asm volatile("s_waitcnt lgkmcnt(0)" ::: "memory");
    const int c = lane & 7;
#pragma unroll
    for (int j = 0; j < 4; ++j) { const int n = (lane >> 3) + 8 * j; const LAS float* s = scr + (8 * c) * 33 + n;
        u32x4 o; o.x = pk2(s[0 * 33], s[1 * 33]); o.y = pk2(s[2 * 33], s[3 * 33]); o.z = pk2(s[4 * 33], s[5 * 33]); o.w = pk2(s[6 * 33], s[7 * 33]);
        *(u32x4*)(dst + (size_t)n * K + k0 + 8 * c) = o; }
    asm volatile("s_waitcnt lgkmcnt(0)" ::: "memory");
}
DI void rms_row(const float* xrow, const float* g, bf16* orow, float* xcopy, int lane) {
    f32x4 v[4]; float s = 0.f;
#pragma unroll
    for (int j = 0; j < 4; ++j) { v[j] = *(const f32x4*)(xrow + 256 * j + 4 * lane); s += (v[j].x * v[j].x + v[j].y * v[j].y) + (v[j].z * v[j].z + v[j].w * v[j].w); }
    const float rstd = 1.0f / sqrtf(wave_sum(s, lane) * (1.f / 1024.f) + EPS);
#pragma unroll
    for (int j = 0; j < 4; ++j) { const f32x4 gg = *(const f32x4*)(g + 256 * j + 4 * lane);
        if (xcopy) *(f32x4*)(xcopy + 256 * j + 4 * lane) = v[j];
        u32x2 o; o.x = pk2(v[j].x * rstd * gg.x, v[j].y * rstd * gg.y); o.y = pk2(v[j].z * rstd * gg.z, v[j].w * rstd * gg.w);
        *(u32x2*)(orow + 256 * j + 4 * lane) = o; }
}
DI void phase_weights(const Params& p, int l, LAS unsigned char* lds, int wg0, int nwg) {
    int tid_o = threadIdx.x; asm volatile("" : "+v"(tid_o)); const int tid = tid_o, lane = tid & 63, wave = tid >> 6;
    const int gw = ((int)blockIdx.x - wg0) * 8 + wave, NGW = nwg * 8;
    if ((int)blockIdx.x < wg0 || (int)blockIdx.x >= wg0 + nwg) return;
    LAS float* scr = (LAS float*)(lds + wave * 16384);
    unsigned char* ws = p.ws + (l ? WS_W1OFS : 0);
    bf16* Win_t = (bf16*)(ws + WS_WIN); bf16* Wq_t = (bf16*)(ws + WS_WQ); bf16* Wk_t = (bf16*)(ws + WS_WK); bf16* Wv_t = (bf16*)(ws + WS_WV);
    bf16* Wo_t = (bf16*)(ws + WS_WO); bf16* Wup_t = (bf16*)(ws + WS_WUP); bf16* Wdn_t = (bf16*)(ws + WS_WDN);
    constexpr int I_IN = 16 * 88, I_Q = 4 * 24, I_KV = 2 * 24, I_O = 16 * 32, I_UP = 16 * 128, I_DN = 64 * 32, I_ZP = 64;
    constexpr int NIT = I_IN + I_Q + I_KV + I_O + I_UP + I_DN + I_ZP;
    for (int it = gw; it < NIT; it += NGW) {
        int r = it;
        if (r < I_IN) { const int kb = r / 88, nb = r % 88; transpose_item(p.in[I_WIN] + (size_t)l * 1024 * DIN, 1024, DIN, Win_t + (size_t)(32 * nb) * 1024, 64 * kb, 32 * nb, scr, lane); continue; } r -= I_IN;
        if (r < I_Q) { const int kb = r / 24, nb = r % 24; transpose_item(p.in[I_WQUP] + (size_t)l * 256 * 576, 256, 576, Wq_t + (size_t)(32 * nb) * 256, 64 * kb, 32 * nb, scr, lane); continue; } r -= I_Q;
        if (r < I_KV) { const int kb = r / 24, nb = r % 24; const int n0 = 32 * nb, hh = n0 / 128, wi = n0 % 128;
            bf16* dst = (wi < 64) ? Wk_t + (size_t)(hh * 64 + wi) * 128 : Wv_t + (size_t)(hh * 64 + wi - 64) * 128;
            transpose_item(p.in[I_WKVUP] + (size_t)l * 128 * 768, 128, 768, dst, 64 * kb, n0, scr, lane); continue; } r -= I_KV;
        if (r < I_O) { const int kb = r / 32, nb = r % 32; transpose_item(p.in[I_WOUT] + (size_t)l * 1024 * 1024, 1024, 1024, Wo_t + (size_t)(32 * nb) * 1024, 64 * kb, 32 * nb, scr, lane); continue; } r -= I_O;
        if (r < I_UP) { const int kb = r / 128, nb = r % 128; transpose_item(p.in[I_WUP] + (size_t)l * 1024 * 4096, 1024, 4096, Wup_t + (size_t)(32 * nb) * 1024, 64 * kb, 32 * nb, scr, lane); continue; } r -= I_UP;
        if (r < I_DN) { const int kb = r / 32, nb = r % 32; transpose_item(p.in[I_WDN] + (size_t)l * 4096 * 1024, 4096, 1024, Wdn_t + (size_t)(32 * nb) * 4096, 64 * kb, 32 * nb, scr, lane); continue; } r -= I_DN;
        {
            bf16* base = (r < 32) ? Wk_t + 384 * 128 : Wv_t + 384 * 128; const int q = r & 31;
            unsigned z0; asm volatile("v_mov_b32 %0, 0" : "=v"(z0)); *(u32x4*)((unsigned char*)base + q * 1024 + lane * 16) = (u32x4){z0, z0, z0, z0}; }
    }
}
DI void phase_P(const Params& p, int l, LAS unsigned char* lds) {
    int tid_o = threadIdx.x; asm volatile("" : "+v"(tid_o)); const int tid = tid_o, lane = tid & 63, wave = tid >> 6;
    const int gw = blockIdx.x * 8 + wave, NGW = gridDim.x * 8;
    unsigned char* ws = p.ws;
    bf16* XN = (bf16*)(ws + WS_XN); float* X = p.out;
    if (l == 0) {
        f32x4 gg[4];
#pragma unroll
        for (int j = 0; j < 4; ++j) gg[j] = *(const f32x4*)(p.in[I_NORM1] + 256 * j + 4 * lane);
        for (int m0 = NGW - 1 - gw; m0 < MT; m0 += 2 * NGW) {
            f32x4 v[2][4]; float s2[2] = {0.f, 0.f}; bool ok[2];
#pragma unroll
            for (int q = 0; q < 2; ++q) { const int m = m0 + q * NGW; ok[q] = m < MT; const int mm = ok[q] ? m : m0;
                const float* src = mm < MP ? p.in[I_XP] + (size_t)mm * DM : p.in[I_XS] + (size_t)(mm - MP) * DM;
#pragma unroll
                for (int j = 0; j < 4; ++j) { v[q][j] = *(const f32x4*)(src + 256 * j + 4 * lane); s2[q] += (v[q][j].x * v[q][j].x + v[q][j].y * v[q][j].y) + (v[q][j].z * v[q][j].z + v[q][j].w * v[q][j].w); } }
#pragma unroll
            for (int o = 1; o < 64; o <<= 1) { const float y0 = shx(s2[0], o, lane), y1 = shx(s2[1], o, lane); s2[0] += y0; s2[1] += y1; }
#pragma unroll
            for (int q = 0; q < 2; ++q) { const int m = m0 + q * NGW; if (!ok[q]) continue;
                const float rstd = 1.0f / sqrtf(s2[q] * (1.f / 1024.f) + EPS);
#pragma unroll
                for (int j = 0; j < 4; ++j) {
                    if (m >= MP) *(f32x4*)(X + (size_t)m * DM + 256 * j + 4 * lane) = v[q][j];
                    u32x2 o; o.x = pk2(v[q][j].x * rstd * gg[j].x, v[q][j].y * rstd * gg[j].y); o.y = pk2(v[q][j].z * rstd * gg[j].z, v[q][j].w * rstd * gg[j].w);
                    *(u32x2*)(XN + (size_t)m * DM + 256 * j + 4 * lane) = o; } }
        }
    }
    {
        const float* c1 = p.in[I_CCKV] + (size_t)l * DBAT * PAST * 128; bf16* d1 = (bf16*)(ws + WS_CKV) + (size_t)MT * 128;
        constexpr int N1 = DBAT * PAST * 128 / 512, N2 = DBAT * PAST * 32 / 512;
        const float* c2 = p.in[I_CKR] + (size_t)l * DBAT * PAST * 32; bf16* d2 = (bf16*)(ws + WS_KR) + (size_t)MT * 32;
        for (int it0 = gw; it0 < N1 + N2; it0 += 4 * NGW) {
            f32x4 a[4], bq[4];
#pragma unroll
            for (int q = 0; q < 4; ++q) { const int it = it0 + q * NGW; if (it < N1 + N2) { const float* src = it < N1 ? c1 + (size_t)it * 512 : c2 + (size_t)(it - N1) * 512; a[q] = *(const f32x4*)(src + lane * 8); bq[q] = *(const f32x4*)(src + lane * 8 + 4); } }
#pragma unroll
            for (int q = 0; q < 4; ++q) { const int it = it0 + q * NGW; if (it < N1 + N2) { bf16* dst = it < N1 ? d1 + (size_t)it * 512 : d2 + (size_t)(it - N1) * 512;
                *(u32x4*)(dst + lane * 8) = (u32x4){pk2(a[q].x, a[q].y), pk2(a[q].z, a[q].w), pk2(bq[q].x, bq[q].y), pk2(bq[q].z, bq[q].w)}; } }
        }
    }
}
DI void phase_rms(const Params& p, const float* g, bool to_out, int ns, LAS unsigned char* lds) {
    int tid_o = threadIdx.x; asm volatile("" : "+v"(tid_o)); const int tid = tid_o, lane = tid & 63, wave = tid >> 6;
    const int gw = blockIdx.x * 8 + wave, NGW = gridDim.x * 8;
    bf16* XN = (bf16*)(p.ws + WS_XN); float* X = p.out; const float* part = (const float*)(p.ws + WS_PART);
    {
        LAS float* red = (LAS float*)(lds + LDS_MISC + 64);
        const int quarter = wave & 3, col = 256 * quarter + 4 * lane; const f32x4 gq = *(const f32x4*)(g + col);
        for (int base = 0; base < MS; base += 2 * (int)gridDim.x) {
            const int sr = base + 2 * (int)blockIdx.x + (wave >> 2); const bool ok = sr < MS;
            f32x4 v = {0.f, 0.f, 0.f, 0.f};
            if (ok) {
                float* xr = X + (size_t)(MP + sr) * DM + col; v = *(const f32x4*)xr;
                const float* pr = part + (size_t)sr * DM + col;
                for (int z = 0; z < ns; z += 4) {
                    f32x4 t[4];
#pragma unroll
                    for (int zz = 0; zz < 4; ++zz) t[zz] = *(const f32x4*)(pr + (size_t)(z + zz) * MS * DM);
#pragma unroll
                    for (int zz = 0; zz < 4; ++zz) v = v + t[zz];
                }
            }
            const float ssq = wave_sum((v.x * v.x + v.y * v.y) + (v.z * v.z + v.w * v.w), lane);
            if (lane == 0) red[wave] = ssq;
            __syncthreads();
            const int w4 = wave & 4; const float tot = (red[w4] + red[w4 + 1]) + (red[w4 + 2] + red[w4 + 3]);
            const float rstd = 1.0f / sqrtf(tot * (1.f / 1024.f) + EPS);
            if (ok) {
                float* xr = X + (size_t)(MP + sr) * DM + col;
                if (to_out) *(f32x4*)xr = v * rstd * gq;
                else { if (ns > 0) *(f32x4*)xr = v;
                    u32x2 o; o.x = pk2(v.x * rstd * gq.x, v.y * rstd * gq.y); o.y = pk2(v.z * rstd * gq.z, v.w * rstd * gq.w);
                    *(u32x2*)(XN + (size_t)(MP + sr) * DM + col) = o; }
            }
            __syncthreads();
        }
    }
    f32x4 gg[4];
#pragma unroll
    for (int j = 0; j < 4; ++j) gg[j] = *(const f32x4*)(g + 256 * j + 4 * lane);
    for (int m0 = gw; m0 < MP; m0 += 2 * NGW) {
        f32x4 v[2][4]; float s[2] = {0.f, 0.f}; bool ok[2];
#pragma unroll
        for (int q = 0; q < 2; ++q) { const int m = m0 + q * NGW; ok[q] = m < MP; const float* xr = X + (size_t)(ok[q] ? m : m0) * DM;
#pragma unroll
            for (int j = 0; j < 4; ++j) v[q][j] = *(const f32x4*)(xr + 256 * j + 4 * lane); }
#pragma unroll
        for (int q = 0; q < 2; ++q) {
#pragma unroll
            for (int j = 0; j < 4; ++j) s[q] += (v[q][j].x * v[q][j].x + v[q][j].y * v[q][j].y) + (v[q][j].z * v[q][j].z + v[q][j].w * v[q][j].w);
        }
#pragma unroll
        for (int o = 1; o < 64; o <<= 1) { const float y0 = shx(s[0], o, lane), y1 = shx(s[1], o, lane); s[0] += y0; s[1] += y1; }
#pragma unroll
        for (int q = 0; q < 2; ++q) { const int m = m0 + q * NGW; if (!ok[q]) continue;
            const float rstd = 1.0f / sqrtf(s[q] * (1.f / 1024.f) + EPS); float* xr = X + (size_t)m * DM;
#pragma unroll
            for (int j = 0; j < 4; ++j) {
                if (to_out) *(f32x4*)(xr + 256 * j + 4 * lane) = v[q][j] * rstd * gg[j];
                else { u32x2 o; o.x = pk2(v[q][j].x * rstd * gg[j].x, v[q][j].y * rstd * gg[j].y); o.y = pk2(v[q][j].z * rstd * gg[j].z, v[q][j].w * rstd * gg[j].w);
                    *(u32x2*)(XN + (size_t)m * DM + 256 * j + 4 * lane) = o; } }
        }
    }
}

template <int NT>
DI void token_part(const Params& p, int l, int row0, int rstride, int lane) {
    const bf16* Zb = (const bf16*)(p.ws + WS_Z);
    u32x2 qw[NT]; unsigned cw[NT]; float k1[NT], k2[NT]; int row[NT]; bool ok[NT];
#pragma unroll
    for (int q = 0; q < NT; ++q) {
        const int rr = row0 + q * rstride; ok[q] = rr < MT; row[q] = ok[q] ? rr : row0;
        const bf16* zr = Zb + (size_t)row[q] * DIN;
        qw[q] = *(const u32x2*)(zr + C_QLAT + 4 * lane); cw[q] = *(const unsigned*)(zr + C_CKV + 2 * lane);
        k1[q] = bf2f(zr[C_KR + (lane & 15)]); k2[q] = bf2f(zr[C_KR + 16 + (lane & 15)]);
    }
    float a[NT][4], cc[NT][2], ss[2 * NT];
#pragma unroll
    for (int q = 0; q < NT; ++q) {
        a[q][0] = __uint_as_float(qw[q].x << 16); a[q][1] = __uint_as_float(qw[q].x & 0xffff0000u); a[q][2] = __uint_as_float(qw[q].y << 16); a[q][3] = __uint_as_float(qw[q].y & 0xffff0000u);
        cc[q][0] = __uint_as_float(cw[q] << 16); cc[q][1] = __uint_as_float(cw[q] & 0xffff0000u);
        ss[2 * q] = (a[q][0] * a[q][0] + a[q][1] * a[q][1]) + (a[q][2] * a[q][2] + a[q][3] * a[q][3]); ss[2 * q + 1] = cc[q][0] * cc[q][0] + cc[q][1] * cc[q][1];
    }
#pragma unroll
    for (int o = 1; o < 64; o <<= 1) {
        float y[2 * NT];
#pragma unroll
        for (int j = 0; j < 2 * NT; ++j) y[j] = shx(ss[j], o, lane);
#pragma unroll
        for (int j = 0; j < 2 * NT; ++j) ss[j] += y[j];
    }
    const f32x4 gq = *(const f32x4*)(p.in[I_QNORM] + l * 256 + 4 * lane); const f32x2 gk = *(const f32x2*)(p.in[I_KVNORM] + l * 128 + 2 * lane);
    const float inv = rope_inv(lane & 15);
#pragma unroll
    for (int q = 0; q < NT; ++q) {
        if (!ok[q]) continue;
        const int rw = row[q]; const bool prompt = rw < MP;
        const int b = prompt ? rw / SEQ : (rw - MP) / DSEQ, t = prompt ? rw % SEQ : (rw - MP) % DSEQ; const int pos = prompt ? t : PAST + t;
        {
            const float rstd = 1.0f / sqrtf(ss[2 * q] * (1.f / 256.f) + EPS);
            u32x2 o; o.x = pk2(a[q][0] * rstd * gq.x, a[q][1] * rstd * gq.y); o.y = pk2(a[q][2] * rstd * gq.z, a[q][3] * rstd * gq.w);
            *(u32x2*)((bf16*)(p.ws + WS_QN) + (size_t)rw * 256 + 4 * lane) = o; }
        {
            const float rstd = 1.0f / sqrtf(ss[2 * q + 1] * (1.f / 128.f) + EPS);
            const float c0 = cc[q][0] * rstd * gk.x, c1 = cc[q][1] * rstd * gk.y;
            float* dst = prompt ? p.out + O_PCKV + ((size_t)(l * NBAT + b) * SEQ + t) * 128 : p.out + O_SCKV + ((size_t)(l * DBAT + b) * DSEQ + t) * 128;
            *(f32x2*)(dst + 2 * lane) = (f32x2){c0, c1};
            *(unsigned*)((bf16*)(p.ws + WS_CKV) + (size_t)rw * 128 + 2 * lane) = pk2(c0, c1); }
        if (lane < 16) {
            float sn, cs; sincos_pos((float)pos * inv, sn, cs);
            const float o1 = k1[q] * cs - k2[q] * sn, o2 = k2[q] * cs + k1[q] * sn;
            float* dst = prompt ? p.out + O_PKR + ((size_t)(l * NBAT + b) * SEQ + t) * 32 : p.out + O_SKR + ((size_t)(l * DBAT + b) * DSEQ + t) * 32;
            dst[lane] = o1; dst[16 + lane] = o2;
            bf16* kd = (bf16*)(p.ws + WS_KR) + (size_t)rw * 32; kd[lane] = f2bf(o1); kd[16 + lane] = f2bf(o2); }
    }
}

DI void cakv_row_out(const Params& p, int l, int j, int lane) {
    const bool prompt = j < 1024; const int b = prompt ? j >> 9 : (j - 1024) / DSEQ, t = prompt ? j & 511 : (j - 1024) % DSEQ;
    const int rw = prompt ? b * SEQ + (SEQ - 512) + t : MP + (j - 1024);
    const bf16* zr = (const bf16*)(p.ws + WS_Z) + (size_t)rw * DIN;
    float* dk = prompt ? p.out + O_PCAK + ((size_t)(l * NBAT + b) * 512 + t) * 384 : p.out + O_SCAK + ((size_t)(l * DBAT + b) * DSEQ + t) * 384;
    float* dv = prompt ? p.out + O_PCAV + ((size_t)(l * NBAT + b) * 512 + t) * 384 : p.out + O_SCAV + ((size_t)(l * DBAT + b) * DSEQ + t) * 384;
    bf16 kk[6], vv[6];
#pragma unroll
    for (int q = 0; q < 6; ++q) { kk[q] = zr[C_CK + 64 * q + lane]; vv[q] = zr[C_CV + 64 * q + lane]; }
#pragma unroll
    for (int q = 0; q < 6; ++q) { dk[64 * q + lane] = bf2f(kk[q]); dv[64 * q + lane] = bf2f(vv[q]); }
}

constexpr int GLP = 72;
DI void gla_load_glr(const bf16* Z, int R0, int T, int lane, float (&glr)[16]) {
    const bf16* gp = Z + (size_t)(R0 + (lane < T ? lane : 0)) * DIN + C_GLR;
    const u32x4 a = *(const u32x4*)gp, bq = *(const u32x4*)(gp + 8);
    const unsigned ww[8] = {a.x, a.y, a.z, a.w, bq.x, bq.y, bq.z, bq.w};
#pragma unroll
    for (int i = 0; i < 8; ++i) { glr[2 * i] = __uint_as_float(ww[i] << 16); glr[2 * i + 1] = __uint_as_float(ww[i] & 0xffff0000u); }
}
DI void gla_b8(const float (&glr)[16], const float* W2, const float* gbias, int col0, int T, int lane, float (&la)[8]) {
#pragma unroll
    for (int jj = 0; jj < 8; ++jj) la[jj] = gbias[col0 + jj];
#pragma unroll
    for (int i = 0; i < 16; ++i)
#pragma unroll
        for (int jj = 0; jj < 8; ++jj) la[jj] += glr[i] * W2[i * 256 + col0 + jj];
#pragma unroll
    for (int jj = 0; jj < 8; ++jj) { const float x = la[jj]; float v = (fminf(x, 0.f) - __logf(1.f + __expf(-fabsf(x)))) * (1.f / 16.f); if (lane >= T) v = 0.f; la[jj] = v; }
#pragma unroll
    for (int o = 1; o < 64; o <<= 1) {
        float y[8];
#pragma unroll
        for (int jj = 0; jj < 8; ++jj) y[jj] = __int_as_float(__builtin_amdgcn_ds_bpermute(((lane - o) & 63) << 2, __float_as_int(la[jj])));
        if (lane >= o) {
#pragma unroll
            for (int jj = 0; jj < 8; ++jj) la[jj] += y[jj]; }
    }
}
DI void unpack8(const u32x4 v, float (&f)[8]) {
    const unsigned w[4] = {v.x, v.y, v.z, v.w};
#pragma unroll
    for (int i = 0; i < 4; ++i) { f[2 * i] = __uint_as_float(w[i] << 16); f[2 * i + 1] = __uint_as_float(w[i] & 0xffff0000u); }
}
constexpr int GU_KD = 0, GU_V = 36864, GU_BL = 73728;
DI void gla_u_unit(const Params& p, LAS unsigned char* lds, int l, int b, int c) {
    int tid_o = threadIdx.x; asm volatile("" : "+v"(tid_o)); const int tid = tid_o, lane = tid & 63, w = __builtin_amdgcn_readfirstlane(tid >> 6), r = lane & 31, h2 = lane >> 5;
    const int R0 = b * SEQ + 64 * c;
    const bf16* Z = (const bf16*)(p.ws + WS_Z);
    LAS bf16* KdT = (LAS bf16*)(lds + GU_KD); LAS bf16* VTs = (LAS bf16*)(lds + GU_V); LAS float* Bl = (LAS float*)(lds + GU_BL);
    const float* W2 = p.in[I_WG2] + (size_t)l * 16 * 256; const float* gbias = p.in[I_GBIAS] + l * 256;
    { const int st = tid >> 3, sc8 = tid & 7; const bf16* zr = Z + (size_t)(R0 + st) * DIN + C_GV + 8 * sc8;
        u32x4 v4[4];
#pragma unroll
        for (int hh = 0; hh < 4; ++hh) v4[hh] = *(const u32x4*)(zr + hh * 64);
#pragma unroll
        for (int hh = 0; hh < 4; ++hh) { const unsigned vv[4] = {v4[hh].x, v4[hh].y, v4[hh].z, v4[hh].w};
#pragma unroll
            for (int j = 0; j < 4; ++j) { VTs[(hh * 64 + 8 * sc8 + 2 * j) * GLP + st] = (bf16)(vv[j] & 0xffffu); VTs[(hh * 64 + 8 * sc8 + 2 * j + 1) * GLP + st] = (bf16)(vv[j] >> 16); } } }
    {
        float glr[16]; gla_load_glr(Z, R0, 64, lane, glr);
        const int hh = w >> 1, dk0 = 32 * (w & 1);
        const bf16* kr = Z + (size_t)(R0 + lane) * DIN + C_GK + hh * 64 + dk0;
        u32x4 k4[4];
#pragma unroll
        for (int g = 0; g < 4; ++g) k4[g] = *(const u32x4*)(kr + 8 * g);
#pragma unroll
        for (int g = 0; g < 4; ++g) {
            float la[8]; gla_b8(glr, W2, gbias, hh * 64 + dk0 + 8 * g, 64, lane, la);
            float kf[8]; unpack8(k4[g], kf);
#pragma unroll
            for (int jj = 0; jj < 8; ++jj) { const float bl = __int_as_float(__builtin_amdgcn_readlane(__float_as_int(la[jj]), 63)); const int dk = dk0 + 8 * g + jj;
                KdT[(hh * 64 + dk) * GLP + lane] = f2bf(kf[jj] * __expf(bl - la[jj])); if (lane == 63) Bl[hh * 64 + dk] = bl; }
        }
    }
    __syncthreads();
#pragma unroll
    for (int q2 = 0; q2 < 2; ++q2) {
        const int id = 2 * w + q2, hh = id >> 2, bdk = id & 1, bdv = (id >> 1) & 1;
        f32x16 acc = {};
#pragma unroll
        for (int s = 0; s < 4; ++s) { const bf16x8 a = *(const LAS bf16x8*)(KdT + (hh * 64 + 32 * bdk + r) * GLP + 16 * s + 8 * h2), bb = *(const LAS bf16x8*)(VTs + (hh * 64 + 32 * bdv + r) * GLP + 16 * s + 8 * h2);
            acc = MFMA32(a, bb, acc); }
        float* U = (float*)(p.ws + WS_GU) + ((size_t)((b * 4 + hh) * 128 + c)) * 4096;
#pragma unroll
        for (int i = 0; i < 16; ++i) U[(32 * bdk + crow(i, h2)) * 64 + 32 * bdv + r] = acc[i];
        if (bdv == 0 && h2 == 0) { float* A = (float*)(p.ws + WS_GA) + ((size_t)((b * 4 + hh) * 128 + c)) * 64; A[32 * bdk + r] = __expf(Bl[hh * 64 + 32 * bdk + r]); }
    }
    __syncthreads();
}
constexpr int GO_SLOT = 62720, GO_Q = 0, GO_K = 9216, GO_KD = 18432, GO_V = 27648, GO_A = 36864, GO_O = 46080, GO_BL = 2 * GO_SLOT;
template <bool SAMPLE>
DI void gla_o_unit(const Params& p, LAS unsigned char* lds, int l, int b, int c) {
    int tid_o = threadIdx.x; asm volatile("" : "+v"(tid_o)); const int tid = tid_o, lane = tid & 63, w = __builtin_amdgcn_readfirstlane(tid >> 6), r = lane & 31, h2 = lane >> 5;
    const int R0 = SAMPLE ? MP + b * DSEQ : b * SEQ + 64 * c; const int T = SAMPLE ? DSEQ : 64;
    const bf16* Z = (const bf16*)(p.ws + WS_Z);
    const int hs = w >> 2, wq = w & 3;
    LAS unsigned char* slot = lds + hs * GO_SLOT;
    LAS bf16* Qs = (LAS bf16*)(slot + GO_Q); LAS bf16* Ks = (LAS bf16*)(slot + GO_K); LAS bf16* KdT = (LAS bf16*)(slot + GO_KD); LAS bf16* VTs = (LAS bf16*)(slot + GO_V);
    LAS bf16* Am = (LAS bf16*)(slot + GO_A); LAS float* Om = (LAS float*)(slot + GO_O); LAS float* Bl = (LAS float*)(lds + GO_BL) + hs * 64;
    const float* W2 = p.in[I_WG2] + (size_t)l * 16 * 256; const float* gbias = p.in[I_GBIAS] + l * 256;
    const int st = tid >> 3, sc8 = tid & 7;
    float glr[16]; gla_load_glr(Z, R0, T, lane, glr);
#pragma unroll 1
    for (int hp = 0; hp < 2; ++hp) {
        const int hh = 2 * hp + hs;
        const float* S0 = SAMPLE ? p.in[I_SGLA] + ((size_t)((l * DBAT + b) * 4 + hh)) * 4096 : (const float*)(p.ws + WS_GU) + ((size_t)((b * 4 + hh) * 128 + c)) * 4096;
        u32x4 sb[4];
        { const int bv = wq >> 1;
#pragma unroll
          for (int s2 = 0; s2 < 4; ++s2) { const float* sp = S0 + (size_t)(16 * s2 + 8 * h2) * 64 + 32 * bv + r;
              sb[s2].x = pk2(sp[0], sp[64]); sb[s2].y = pk2(sp[128], sp[192]); sb[s2].z = pk2(sp[256], sp[320]); sb[s2].w = pk2(sp[384], sp[448]); } }
        u32x4 g4[2] = {{0u, 0u, 0u, 0u}, {0u, 0u, 0u, 0u}}; f32x4 gn[2][2];
#pragma unroll
        for (int e = 0; e < 2; ++e) { const int he = 2 * hp + e;
            if (st < T) g4[e] = *(const u32x4*)(Z + (size_t)(R0 + st) * DIN + C_GOUT + he * 64 + 8 * sc8);
            const float* gp = p.in[I_GONORM] + l * 256 + he * 64 + 8 * sc8; gn[e][0] = *(const f32x4*)gp; gn[e][1] = *(const f32x4*)(gp + 4); }
        {
            u32x4 v4[2] = {{0u, 0u, 0u, 0u}, {0u, 0u, 0u, 0u}};
            if (st < T) { const bf16* zr = Z + (size_t)(R0 + st) * DIN + C_GV + (2 * hp) * 64 + 8 * sc8; v4[0] = *(const u32x4*)zr; v4[1] = *(const u32x4*)(zr + 64); }
#pragma unroll
            for (int e = 0; e < 2; ++e) { LAS bf16* VT2 = (LAS bf16*)(lds + e * GO_SLOT + GO_V); const unsigned vv[4] = {v4[e].x, v4[e].y, v4[e].z, v4[e].w};
#pragma unroll
                for (int j = 0; j < 4; ++j) { VT2[(8 * sc8 + 2 * j) * GLP + st] = (bf16)(vv[j] & 0xffffu); VT2[(8 * sc8 + 2 * j + 1) * GLP + st] = (bf16)(vv[j] >> 16); } }
            const int dk0 = 16 * wq;
            u32x4 q4[2] = {{0u, 0u, 0u, 0u}, {0u, 0u, 0u, 0u}}, k4[2] = {{0u, 0u, 0u, 0u}, {0u, 0u, 0u, 0u}};
            if (lane < T) { const bf16* zr = Z + (size_t)(R0 + lane) * DIN + hh * 64 + dk0;
                q4[0] = *(const u32x4*)(zr + C_GQ); q4[1] = *(const u32x4*)(zr + C_GQ + 8); k4[0] = *(const u32x4*)(zr + C_GK); k4[1] = *(const u32x4*)(zr + C_GK + 8); }
#pragma unroll
            for (int g = 0; g < 2; ++g) {
                float la[8]; gla_b8(glr, W2, gbias, hh * 64 + dk0 + 8 * g, T, lane, la);
                float qf[8], kf[8]; unpack8(q4[g], qf); unpack8(k4[g], kf);
                float qt[8], kt[8];
#pragma unroll
                for (int jj = 0; jj < 8; ++jj) { const float bl = __int_as_float(__builtin_amdgcn_readlane(__float_as_int(la[jj]), 63)); const int dk = dk0 + 8 * g + jj;
                    qt[jj] = qf[jj] * 0.125f * __expf(la[jj]); kt[jj] = kf[jj] * __expf(-la[jj]);
                    if (SAMPLE) KdT[dk * GLP + lane] = f2bf(kf[jj] * __expf(bl - la[jj]));
                    if (lane == 63) Bl[dk] = bl; }
                *(LAS u32x4*)(Qs + lane * GLP + dk0 + 8 * g) = (u32x4){pk2(qt[0], qt[1]), pk2(qt[2], qt[3]), pk2(qt[4], qt[5]), pk2(qt[6], qt[7])};
                *(LAS u32x4*)(Ks + lane * GLP + dk0 + 8 * g) = (u32x4){pk2(kt[0], kt[1]), pk2(kt[2], kt[3]), pk2(kt[4], kt[5]), pk2(kt[6], kt[7])};
            }
        }
        __syncthreads();
        {
            const int bi = (wq == 0) ? 0 : 1, bj = (wq == 2) ? 1 : 0;
            if (wq < 3) {
                f32x16 acc = {};
#pragma unroll
                for (int s = 0; s < 4; ++s) { const bf16x8 a = *(const LAS bf16x8*)(Qs + (32 * bi + r) * GLP + 16 * s + 8 * h2), bb = *(const LAS bf16x8*)(Ks + (32 * bj + r) * GLP + 16 * s + 8 * h2);
                    acc = MFMA32(a, bb, acc); }
#pragma unroll
                for (int i = 0; i < 16; ++i) { const int ii = 32 * bi + crow(i, h2), jj = 32 * bj + r; Am[ii * GLP + jj] = f2bf(jj <= ii ? acc[i] : 0.f); }
            } else {
#pragma unroll
                for (int i = 0; i < 16; ++i) Am[crow(i, h2) * GLP + 32 + r] = 0;
            }
            if (SAMPLE) {
                const int bdk = wq & 1, bdv = wq >> 1;
                f32x16 acc = {};
#pragma unroll
                for (int s = 0; s < 4; ++s) { const bf16x8 a = *(const LAS bf16x8*)(KdT + (32 * bdk + r) * GLP + 16 * s + 8 * h2), bb = *(const LAS bf16x8*)(VTs + (32 * bdv + r) * GLP + 16 * s + 8 * h2);
                    acc = MFMA32(a, bb, acc); }
                float* S1 = p.out + O_SGLA + ((size_t)((l * DBAT + b) * 4 + hh)) * 4096;
#pragma unroll
                for (int i = 0; i < 16; ++i) { const int dk = 32 * bdk + crow(i, h2), dv = 32 * bdv + r; S1[dk * 64 + dv] = __expf(Bl[dk]) * S0[dk * 64 + dv] + acc[i]; }
            }
        }
        __syncthreads();
        {
            const int bi = wq & 1, bv = wq >> 1;
            f32x16 acc = {};
#pragma unroll
            for (int s = 0; s < 4; ++s) { const bf16x8 a = *(const LAS bf16x8*)(Am + (32 * bi + r) * GLP + 16 * s + 8 * h2), bb = *(const LAS bf16x8*)(VTs + (32 * bv + r) * GLP + 16 * s + 8 * h2);
                acc = MFMA32(a, bb, acc); }
#pragma unroll
            for (int s = 0; s < 4; ++s) { const bf16x8 a = *(const LAS bf16x8*)(Qs + (32 * bi + r) * GLP + 16 * s + 8 * h2);
                acc = MFMA32(a, __builtin_bit_cast(bf16x8, sb[s]), acc); }
#pragma unroll
            for (int i = 0; i < 16; ++i) Om[(32 * bi + crow(i, h2)) * 65 + 32 * bv + r] = acc[i];
        }
        __syncthreads();
#pragma unroll
        for (int e = 0; e < 2; ++e) {
            const LAS float* Om2 = (const LAS float*)(lds + e * GO_SLOT + GO_O); const int he = 2 * hp + e;
            float o8[8]; float ss = 0.f;
#pragma unroll
            for (int j = 0; j < 8; ++j) { o8[j] = Om2[st * 65 + 8 * sc8 + j]; ss += o8[j] * o8[j]; }
            ss += shx(ss, 1, lane); ss += shx(ss, 2, lane); ss += shx(ss, 4, lane);
            const float rstd = 1.0f / sqrtf(ss * (1.f / 64.f) + EPS);
            if (st < T) {
                float go[8]; unpack8(g4[e], go);
                const float gnn[8] = {gn[e][0].x, gn[e][0].y, gn[e][0].z, gn[e][0].w, gn[e][1].x, gn[e][1].y, gn[e][1].z, gn[e][1].w};
                float vals[8];
#pragma unroll
                for (int j = 0; j < 8; ++j) { const float si = go[j] / (1.f + __expf(-go[j])); vals[j] = o8[j] * rstd * gnn[j] * si; }
                *(u32x4*)((bf16*)(p.ws + WS_XN) + (size_t)(R0 + st) * DM + 384 + he * 64 + 8 * sc8) = (u32x4){pk2(vals[0], vals[1]), pk2(vals[2], vals[3]), pk2(vals[4], vals[5]), pk2(vals[6], vals[7])};
            }
        }
    }
    __syncthreads();
}

DI void gla_scan(const Params& p, int l) {
    const int tid = threadIdx.x;
    if (tid >= 128) return;
    for (int wg = blockIdx.x; wg < 256; wg += gridDim.x) {
        const int bh = wg >> 5, e = (wg & 31) * 128 + tid, dk = e >> 6;
        float* U = (float*)(p.ws + WS_GU) + (size_t)bh * 128 * 4096 + e; const float* A = (const float*)(p.ws + WS_GA) + (size_t)bh * 128 * 64 + dk;
        float s = 0.f;
#pragma unroll 1
        for (int c0 = 0; c0 < 128; c0 += 16) {
            float u[16], a[16];
#pragma unroll
            for (int i = 0; i < 16; ++i) { u[i] = U[(size_t)(c0 + i) * 4096]; a[i] = A[(c0 + i) * 64]; }
#pragma unroll
            for (int i = 0; i < 16; ++i) { U[(size_t)(c0 + i) * 4096] = s; s = a[i] * s + u[i]; }
        }
        p.out[O_PGLA + ((size_t)(l * NBAT * 4 + bh)) * 4096 + e] = s;
    }
}

constexpr int AT_K0 = 0, AT_KB = 13312, AT_V0 = 26624, AT_VB = 8704, AT_VP = 68, AT_TAB = 44032;
template <int MODE>
DI void attn_unit(const Params& p, LAS unsigned char* lds, int l, int b, int h, int qb) {
    constexpr bool MLA = (MODE == 0 || MODE == 2), SAMPLE = (MODE >= 2);
    constexpr int NKS = MLA ? 6 : 4, KP = MLA ? 104 : 72;
    int tid_o = threadIdx.x; asm volatile("" : "+v"(tid_o)); const int tid = tid_o, lane = tid & 63, w = __builtin_amdgcn_readfirstlane(tid >> 6), r = lane & 31, h2 = lane >> 5;
    const bf16* Z = (const bf16*)(p.ws + WS_Z); const bf16* KN = (const bf16*)(p.ws + WS_KN); const bf16* KR = (const bf16*)(p.ws + WS_KR);
    const bf16* VT = (const bf16*)(p.ws + WS_VT); const bf16* QM = (const bf16*)(p.ws + WS_QM);
    int t_first, t_last, wt_lo, wt_hi, qrow, qpos, qmin;
    if (!SAMPLE) {
        const int cw = 4 * qb + (w >> 1);
        t_last = 4 * qb + 3; wt_hi = cw;
        if (MLA) { t_first = 0; wt_lo = 0; } else { t_first = 4 * qb - 8 > 0 ? 4 * qb - 8 : 0; wt_lo = cw - 8 > 0 ? cw - 8 : 0; }
        qpos = 256 * qb + 32 * w + r; qrow = b * SEQ + qpos; qmin = 256 * qb + 32 * w;
    } else {
        t_first = 0; t_last = MLA ? 16 : 8; wt_lo = 0; wt_hi = (w == 0) ? t_last : -1;
        const int qi = r & 15; qrow = MP + b * DSEQ + qi; qpos = (MLA ? PAST : 512) + qi; qmin = MLA ? PAST : 512;
    }
    const float sc = (MLA ? 0.10206207261596577f : 0.125f) * LOG2E;
    bf16x8 q[NKS];
    if (MLA) {
        const bf16* src = QM + (size_t)qrow * 576 + h * 96 + 8 * h2;
#pragma unroll
        for (int s = 0; s < NKS; ++s) q[s] = *(const bf16x8*)(src + 16 * s);
#pragma unroll
        for (int j = 0; j < 8; ++j) { float sn, cs; sincos_pos((float)qpos * rope_inv(8 * h2 + j), sn, cs);
            const float x1 = bf2f((bf16)q[4][j]), x2 = bf2f((bf16)q[5][j]);
            q[4][j] = (short)f2bf((x1 * cs - x2 * sn) * sc); q[5][j] = (short)f2bf((x2 * cs + x1 * sn) * sc); }
#pragma unroll
        for (int s = 0; s < 4; ++s)
#pragma unroll
            for (int j = 0; j < 8; ++j) q[s][j] = (short)f2bf(bf2f((bf16)q[s][j]) * sc);
    } else {
        const bf16* src = Z + (size_t)qrow * DIN + C_CQ + h * 64 + 8 * h2;
#pragma unroll
        for (int s = 0; s < NKS; ++s) q[s] = *(const bf16x8*)(src + 16 * s);
#pragma unroll
        for (int s = 0; s < NKS; ++s)
#pragma unroll
            for (int j = 0; j < 8; ++j) q[s][j] = (short)f2bf(bf2f((bf16)q[s][j]) * sc);
    }
    LAS float* tab = (LAS float*)(lds + AT_TAB);
    if (!MLA) { if (tid < 257) tab[tid] = p.in[I_RELB][(size_t)l * 257 * 6 + tid * 6 + h] * LOG2E; }
    float m = (MODE <= 1) ? 0.f : -INFINITY, lsum = 0.f; f32x16 O0 = {}, O1 = {};
    f32x16 negm = {}, negmb = {};
    float b0u = 0.f;
    struct TileRegs { u32x4 k0, k1, v; };
    TileRegs RA, RB; RA.k0 = (u32x4){0u, 0u, 0u, 0u}; RA.k1 = RA.k0; RA.v = RA.k0; RB = RA;
    auto load_tile = [&](int t, TileRegs& R) {
        if (MODE == 0 || MODE == 2) {
            int rb; if (MODE == 0) rb = b * SEQ + 64 * t; else rb = (t < 16) ? MT + b * PAST + 64 * t : MP + b * DSEQ;
            { const int idx = tid, key = idx / 12, c = idx % 12;
              R.k0 = (c < 8) ? *(const u32x4*)(KN + (size_t)(rb + key) * 384 + h * 64 + 8 * c) : *(const u32x4*)(KR + (size_t)(rb + key) * 32 + 8 * (c - 8)); }
            if (tid < 256) { const int idx = tid + 512, key = idx / 12, c = idx % 12;
              R.k1 = (c < 8) ? *(const u32x4*)(KN + (size_t)(rb + key) * 384 + h * 64 + 8 * c) : *(const u32x4*)(KR + (size_t)(rb + key) * 32 + 8 * (c - 8)); }
            { const int d = tid >> 3, c = tid & 7; R.v = *(const u32x4*)(VT + (size_t)(h * 64 + d) * RALL + rb + 8 * c); }
        } else if (MODE == 1) {
            const int rb = b * SEQ + 64 * t; const int key = tid >> 3, c = tid & 7;
            const bf16* zr = Z + (size_t)(rb + key) * DIN + h * 64 + 8 * c;
            R.k0 = *(const u32x4*)(zr + C_CK); R.v = *(const u32x4*)(zr + C_CV);
        } else {
            const int key = tid >> 3, c = tid & 7;
            if (t < 8) {
                const size_t off = (((size_t)(l * DBAT + b) * 512 + 64 * t + key) * 6 + h) * 64 + 8 * c;
                const float* kp = p.in[I_CCAK] + off; const float* vp = p.in[I_CCAV] + off;
                const f32x4 a = *(const f32x4*)kp, a2 = *(const f32x4*)(kp + 4), bq = *(const f32x4*)vp, b2 = *(const f32x4*)(vp + 4);
                R.k0 = (u32x4){pk2(a.x, a.y), pk2(a.z, a.w), pk2(a2.x, a2.y), pk2(a2.z, a2.w)};
                R.v = (u32x4){pk2(bq.x, bq.y), pk2(bq.z, bq.w), pk2(b2.x, b2.y), pk2(b2.z, b2.w)};
            } else {
                const bf16* zr = Z + (size_t)(MP + b * DSEQ + (key & 15)) * DIN + h * 64 + 8 * c;
                R.k0 = *(const u32x4*)(zr + C_CK); R.v = *(const u32x4*)(zr + C_CV);
            }
        }
    };
    auto store_tile = [&](int buf, const TileRegs& R) {
        LAS unsigned char* Kb = lds + AT_K0 + buf * AT_KB; LAS unsigned char* Vb = lds + AT_V0 + buf * AT_VB;
        if (MLA) {
            { const int idx = tid, key = idx / 12, c = idx % 12; *(LAS u32x4*)(Kb + key * (KP * 2) + c * 16) = R.k0; }
            if (tid < 256) { const int idx = tid + 512, key = idx / 12, c = idx % 12; *(LAS u32x4*)(Kb + key * (KP * 2) + c * 16) = R.k1; }
            { const int d = tid >> 3, c = tid & 7; LAS unsigned char* dp = Vb + d * (AT_VP * 2) + c * 16;
              *(LAS u32x2*)dp = (u32x2){R.v.x, R.v.y}; *(LAS u32x2*)(dp + 8) = (u32x2){R.v.z, R.v.w}; }
        } else {
            const int key = tid >> 3, c = tid & 7;
            *(LAS u32x4*)(Kb + key * (KP * 2) + c * 16) = R.k0;
            const unsigned vv[4] = {R.v.x, R.v.y, R.v.z, R.v.w};
#pragma unroll
            for (int j = 0; j < 4; ++j) { *(LAS bf16*)(Vb + (8 * c + 2 * j) * (AT_VP * 2) + key * 2) = (bf16)(vv[j] & 0xffffu); *(LAS bf16*)(Vb + (8 * c + 2 * j + 1) * (AT_VP * 2) + key * 2) = (bf16)(vv[j] >> 16); }
        }
    };
    load_tile(t_first, RA); store_tile(0, RA);
    __syncthreads();
    if (MODE == 1) { b0u = tab[0];
#pragma unroll
        for (int i = 0; i < 16; ++i) negmb[i] = b0u; }
    if (t_first + 1 <= t_last) load_tile(t_first + 1, RA);
    if (t_first + 2 <= t_last) load_tile(t_first + 2, RB);
    auto compute = [&](int t, int cur) {
        if (t >= wt_lo && t <= wt_hi) {
            const LAS unsigned char* Kb = lds + AT_K0 + cur * AT_KB; const LAS unsigned char* Vb = lds + AT_V0 + cur * AT_VB;
            bf16x8 kf[2 * NKS];
#pragma unroll
            for (int s = 0; s < NKS; ++s) { kf[2 * s] = *(const LAS bf16x8*)(Kb + (r * KP + 16 * s + 8 * h2) * 2); kf[2 * s + 1] = *(const LAS bf16x8*)(Kb + ((32 + r) * KP + 16 * s + 8 * h2) * 2); }
            __builtin_amdgcn_sched_barrier(0);
            f32x16 p0, p1;
            const bool cbias = (MODE == 1) && ((64 * t + 63 - qmin) <= -128);
            if (MODE == 0) { p0 = negm; p1 = negm; } else if (MODE == 1) { if (cbias) { p0 = negmb; p1 = negmb; } else { p0 = negm; p1 = negm; } } else { p0 = (f32x16){}; p1 = (f32x16){}; }
            s16x4 vlo0[4], vhi0[4], vlo1[4], vhi1[4];
            const LAS unsigned char* v0b = Vb + (r * AT_VP + 4 * h2) * 2; const LAS unsigned char* v1b = Vb + ((32 + r) * AT_VP + 4 * h2) * 2;
#pragma unroll
            for (int s = 0; s < NKS; ++s) {
                p0 = MFMA32(kf[2 * s], q[s], p0); p1 = MFMA32(kf[2 * s + 1], q[s], p1);
                if (s < 4) { vlo0[s] = *(const LAS s16x4*)(v0b + 32 * s); vhi0[s] = *(const LAS s16x4*)(v0b + 32 * s + 16); vlo1[s] = *(const LAS s16x4*)(v1b + 32 * s); vhi1[s] = *(const LAS s16x4*)(v1b + 32 * s + 16); }
                __builtin_amdgcn_sched_barrier(0);
            }
            float mt = -INFINITY;
            const bool lastpart = SAMPLE && (t == t_last);
            if (MODE == 1 && cbias) {
#pragma unroll
                for (int i = 0; i < 16; ++i) mt = __builtin_amdgcn_fmed3f(__builtin_amdgcn_fmed3f(mt, p0[i], INFINITY), p1[i], INFINITY);
            } else if (!MLA) {
                const float b0 = (MODE == 1) ? 0.f : tab[0];
#pragma unroll
                for (int i = 0; i < 16; ++i) {
                    const int k0 = 64 * t + crow(i, h2), k1 = k0 + 32; float bb0 = b0, bb1 = b0;
                    if (!cbias) { int r0 = k0 - qpos, r1 = k1 - qpos; r0 = r0 < -128 ? -128 : (r0 > 128 ? 128 : r0); r1 = r1 < -128 ? -128 : (r1 > 128 ? 128 : r1);
                        bb0 = tab[r0 + 128]; bb1 = tab[r1 + 128]; }
                    float s0 = p0[i] + bb0, s1 = p1[i] + bb1;
                    if (lastpart) { if (crow(i, h2) >= 16) s0 = -INFINITY; s1 = -INFINITY; }
                    p0[i] = s0; p1[i] = s1; mt = __builtin_amdgcn_fmed3f(__builtin_amdgcn_fmed3f(mt, s0, INFINITY), s1, INFINITY);
                }
            } else {
#pragma unroll
                for (int i = 0; i < 16; ++i) {
                    float s0 = p0[i], s1 = p1[i];
                    if (lastpart) { if (crow(i, h2) >= 16) s0 = -INFINITY; s1 = -INFINITY; }
                    p0[i] = s0; p1[i] = s1; mt = __builtin_amdgcn_fmed3f(__builtin_amdgcn_fmed3f(mt, s0, INFINITY), s1, INFINITY);
                }
            }
            mt = fmaxf(mt, shx(mt, 32, lane));
            float rs = 0.f;
            if (MODE <= 1) {
                const bool first = (t == wt_lo);
                if (first || __builtin_amdgcn_ballot_w64(mt > 8.0f) != 0ull) {
                    const float dl = first ? mt : fmaxf(mt, 0.f);
                    m += dl;
#pragma unroll
                    for (int i = 0; i < 16; ++i) { p0[i] -= dl; p1[i] -= dl; negm[i] = -m; if (MODE == 1) negmb[i] = b0u - m; }
                    if (!first) { const float alpha = __builtin_amdgcn_exp2f(-dl); lsum *= alpha;
#pragma unroll
                        for (int i = 0; i < 16; ++i) { O0[i] *= alpha; O1[i] *= alpha; } }
                }
#pragma unroll
                for (int i = 0; i < 16; ++i) { p0[i] = __builtin_amdgcn_exp2f(p0[i]); p1[i] = __builtin_amdgcn_exp2f(p1[i]); rs += p0[i] + p1[i]; }
            } else {
                const float mn = fmaxf(m, mt);
                if (__builtin_amdgcn_ballot_w64(mn > m) != 0ull) {
                    const float alpha = __builtin_amdgcn_exp2f(m - mn); m = mn; lsum *= alpha;
#pragma unroll
                    for (int i = 0; i < 16; ++i) { O0[i] *= alpha; O1[i] *= alpha; }
                }
#pragma unroll
                for (int i = 0; i < 16; ++i) { p0[i] = __builtin_amdgcn_exp2f(p0[i] - mn); p1[i] = __builtin_amdgcn_exp2f(p1[i] - mn); rs += p0[i] + p1[i]; }
            }
            lsum += rs;
            bf16x8 pb[4];
            { u32x4 x;
              x = (u32x4){pk2(p0[0], p0[1]), pk2(p0[2], p0[3]), pk2(p0[4], p0[5]), pk2(p0[6], p0[7])}; pb[0] = __builtin_bit_cast(bf16x8, x);
              x = (u32x4){pk2(p0[8], p0[9]), pk2(p0[10], p0[11]), pk2(p0[12], p0[13]), pk2(p0[14], p0[15])}; pb[1] = __builtin_bit_cast(bf16x8, x);
              x = (u32x4){pk2(p1[0], p1[1]), pk2(p1[2], p1[3]), pk2(p1[4], p1[5]), pk2(p1[6], p1[7])}; pb[2] = __builtin_bit_cast(bf16x8, x);
              x = (u32x4){pk2(p1[8], p1[9]), pk2(p1[10], p1[11]), pk2(p1[12], p1[13]), pk2(p1[14], p1[15])}; pb[3] = __builtin_bit_cast(bf16x8, x); }
#pragma unroll
            for (int ks = 0; ks < 4; ++ks) {
                const bf16x8 va0 = __builtin_shufflevector(vlo0[ks], vhi0[ks], 0, 1, 2, 3, 4, 5, 6, 7), va1 = __builtin_shufflevector(vlo1[ks], vhi1[ks], 0, 1, 2, 3, 4, 5, 6, 7);
                O0 = MFMA32(va0, pb[ks], O0); O1 = MFMA32(va1, pb[ks], O1);
            }
        }
    };
    int cur = 0;
    for (int t = t_first; t <= t_last; t += 2) {
        compute(t, cur);
        if (t + 1 <= t_last) store_tile(cur ^ 1, RA);
        if (t + 3 <= t_last) load_tile(t + 3, RA);
        asm volatile("s_waitcnt lgkmcnt(0)\n\ts_barrier" ::: "memory");
        cur ^= 1;
        if (t + 1 > t_last) break;
        compute(t + 1, cur);
        if (t + 2 <= t_last) store_tile(cur ^ 1, RB);
        if (t + 4 <= t_last) load_tile(t + 4, RB);
        asm volatile("s_waitcnt lgkmcnt(0)\n\ts_barrier" ::: "memory");
        cur ^= 1;
    }
    const float lt = lsum + shx(lsum, 32, lane);
    const bool valid = SAMPLE ? (w == 0 && r < 16) : true;
    if (valid) {
        const float inv = 1.0f / lt;
        bf16* dst = (bf16*)(p.ws + WS_XN) + (size_t)qrow * DM + (MLA ? 0 : 640) + h * 64 + 4 * h2;
#pragma unroll
        for (int g = 0; g < 4; ++g) {
            *(u32x2*)(dst + 8 * g) = (u32x2){pk2(O0[4 * g] * inv, O0[4 * g + 1] * inv), pk2(O0[4 * g + 2] * inv, O0[4 * g + 3] * inv)};
            *(u32x2*)(dst + 32 + 8 * g) = (u32x2){pk2(O1[4 * g] * inv, O1[4 * g + 1] * inv), pk2(O1[4 * g + 2] * inv, O1[4 * g + 3] * inv)};
        }
    }
}

template <bool MLA>
DI void attn_sample_wave(const Params& p, const LAS float* tabs, int l, int b, int h, int lane) {
    constexpr int NKS = MLA ? 6 : 4, NT = MLA ? 17 : 9;
    const int r = lane & 31, h2 = lane >> 5, qi = r & 15;
    const bf16* Z = (const bf16*)(p.ws + WS_Z); const bf16* KN = (const bf16*)(p.ws + WS_KN); const bf16* KR = (const bf16*)(p.ws + WS_KR);
    const bf16* VT = (const bf16*)(p.ws + WS_VT); const bf16* QM = (const bf16*)(p.ws + WS_QM);
    const int qrow = MP + b * DSEQ + qi, qpos = (MLA ? PAST : 512) + qi;
    const float sc = (MLA ? 0.10206207261596577f : 0.125f) * LOG2E;
    bf16x8 q[NKS];
    if (MLA) {
        const bf16* src = QM + (size_t)qrow * 576 + h * 96 + 8 * h2;
#pragma unroll
        for (int s = 0; s < NKS; ++s) q[s] = *(const bf16x8*)(src + 16 * s);
#pragma unroll
        for (int j = 0; j < 8; ++j) { float sn, cs; sincos_pos((float)qpos * rope_inv(8 * h2 + j), sn, cs);
            const float x1 = bf2f((bf16)q[4][j]), x2 = bf2f((bf16)q[5][j]);
            q[4][j] = (short)f2bf((x1 * cs - x2 * sn) * sc); q[5][j] = (short)f2bf((x2 * cs + x1 * sn) * sc); }
#pragma unroll
        for (int s = 0; s < 4; ++s)
#pragma unroll
            for (int j = 0; j < 8; ++j) q[s][j] = (short)f2bf(bf2f((bf16)q[s][j]) * sc);
    } else {
        const bf16* src = Z + (size_t)qrow * DIN + C_CQ + h * 64 + 8 * h2;
#pragma unroll
        for (int s = 0; s < NKS; ++s) q[s] = *(const bf16x8*)(src + 16 * s);
#pragma unroll
        for (int s = 0; s < NKS; ++s)
#pragma unroll
            for (int j = 0; j < 8; ++j) q[s][j] = (short)f2bf(bf2f((bf16)q[s][j]) * sc);
    }
    const LAS float* tab = tabs + h * 257;
    float m = -INFINITY, lsum = 0.f; f32x16 O0 = {}, O1 = {};
#pragma unroll 1
    for (int t = 0; t < NT; ++t) {
        const bool last = (t == NT - 1);
        bf16x8 kf[2 * NKS];
        if (MLA) {
            const int rb = last ? MP + b * DSEQ : MT + b * PAST + 64 * t;
#pragma unroll
            for (int s = 0; s < 4; ++s) { kf[2 * s] = *(const bf16x8*)(KN + (size_t)(rb + r) * 384 + h * 64 + 16 * s + 8 * h2); kf[2 * s + 1] = *(const bf16x8*)(KN + (size_t)(rb + 32 + r) * 384 + h * 64 + 16 * s + 8 * h2); }
#pragma unroll
            for (int s = 4; s < 6; ++s) { kf[2 * s] = *(const bf16x8*)(KR + (size_t)(rb + r) * 32 + 16 * (s - 4) + 8 * h2); kf[2 * s + 1] = *(const bf16x8*)(KR + (size_t)(rb + 32 + r) * 32 + 16 * (s - 4) + 8 * h2); }
        } else if (!last) {
            const float* kb = p.in[I_CCAK] + (((size_t)(l * DBAT + b) * 512 + 64 * t) * 6 + h) * 64 + 8 * h2;
#pragma unroll
            for (int s = 0; s < 4; ++s)
#pragma unroll
                for (int e = 0; e < 2; ++e) { const float* kp = kb + (size_t)(32 * e + r) * 384 + 16 * s; const f32x4 a = *(const f32x4*)kp, a2 = *(const f32x4*)(kp + 4);
                    const u32x4 x = {pk2(a.x, a.y), pk2(a.z, a.w), pk2(a2.x, a2.y), pk2(a2.z, a2.w)}; kf[2 * s + e] = __builtin_bit_cast(bf16x8, x); }
        } else {
#pragma unroll
            for (int s = 0; s < 4; ++s) { const bf16x8 x = *(const bf16x8*)(Z + (size_t)(MP + b * DSEQ + qi) * DIN + C_CK + h * 64 + 16 * s + 8 * h2); kf[2 * s] = x; kf[2 * s + 1] = x; }
        }
        f32x16 p0 = {}, p1 = {};
#pragma unroll
        for (int s = 0; s < NKS; ++s) { p0 = MFMA32(kf[2 * s], q[s], p0); p1 = MFMA32(kf[2 * s + 1], q[s], p1); }
        bf16x8 va[2][4];
        if (MLA) {
            const int rb = last ? MP + b * DSEQ : MT + b * PAST + 64 * t;
#pragma unroll
            for (int db = 0; db < 2; ++db)
#pragma unroll
                for (int ks = 0; ks < 4; ++ks) { const bf16* vp = VT + (size_t)(h * 64 + 32 * db + r) * RALL + rb + 16 * ks + 4 * h2;
                    const s16x4 lo = *(const s16x4*)vp, hi = *(const s16x4*)(vp + 8); va[db][ks] = __builtin_shufflevector(lo, hi, 0, 1, 2, 3, 4, 5, 6, 7); }
        } else if (!last) {
            const float* vb = p.in[I_CCAV] + (((size_t)(l * DBAT + b) * 512 + 64 * t) * 6 + h) * 64 + r;
#pragma unroll
            for (int db = 0; db < 2; ++db)
#pragma unroll
                for (int ks = 0; ks < 4; ++ks) { const float* vp = vb + (size_t)(16 * ks + 4 * h2) * 384 + 32 * db;
                    const u32x4 x = {pk2(vp[0], vp[384]), pk2(vp[768], vp[1152]), pk2(vp[8 * 384], vp[9 * 384]), pk2(vp[10 * 384], vp[11 * 384])}; va[db][ks] = __builtin_bit_cast(bf16x8, x); }
        } else {
#pragma unroll
            for (int db = 0; db < 2; ++db)
#pragma unroll
                for (int ks = 0; ks < 4; ++ks) { bf16x8 x;
#pragma unroll
                    for (int j = 0; j < 8; ++j) { const int key = (16 * ks + 8 * (j >> 2) + 4 * h2 + (j & 3)) & 15; x[j] = (short)Z[(size_t)(MP + b * DSEQ + key) * DIN + C_CV + h * 64 + 32 * db + r]; }
                    va[db][ks] = x; }
        }
        float mt = -INFINITY;
        if (!MLA) {
            const bool cbias = (64 * t + 63 - 512) <= -128; const float b0 = tab[0];
#pragma unroll
            for (int i = 0; i < 16; ++i) {
                const int k0 = 64 * t + crow(i, h2), k1 = k0 + 32; float bb0 = b0, bb1 = b0;
                if (!cbias) { int r0 = k0 - qpos, r1 = k1 - qpos; r0 = r0 < -128 ? -128 : (r0 > 128 ? 128 : r0); r1 = r1 < -128 ? -128 : (r1 > 128 ? 128 : r1);
                    bb0 = tab[r0 + 128]; bb1 = tab[r1 + 128]; }
                float s0 = p0[i] + bb0, s1 = p1[i] + bb1;
                if (last) { if (crow(i, h2) >= 16) s0 = -INFINITY; s1 = -INFINITY; }
                p0[i] = s0; p1[i] = s1; mt = __builtin_amdgcn_fmed3f(__builtin_amdgcn_fmed3f(mt, s0, INFINITY), s1, INFINITY);
            }
        } else {
#pragma unroll
            for (int i = 0; i < 16; ++i) {
                float s0 = p0[i], s1 = p1[i];
                if (last) { if (crow(i, h2) >= 16) s0 = -INFINITY; s1 = -INFINITY; }
                p0[i] = s0; p1[i] = s1; mt = __builtin_amdgcn_fmed3f(__builtin_amdgcn_fmed3f(mt, s0, INFINITY), s1, INFINITY);
            }
        }
        mt = fmaxf(mt, shx(mt, 32, lane));
        const float mn = fmaxf(m, mt); const float alpha = __builtin_amdgcn_exp2f(m - mn); m = mn; lsum *= alpha;
#pragma unroll
        for (int i = 0; i < 16; ++i) { O0[i] *= alpha; O1[i] *= alpha; }
        float rs = 0.f;
#pragma unroll
        for (int i = 0; i < 16; ++i) { p0[i] = __builtin_amdgcn_exp2f(p0[i] - mn); p1[i] = __builtin_amdgcn_exp2f(p1[i] - mn); rs += p0[i] + p1[i]; }
        lsum += rs;
        bf16x8 pb[4];
        { u32x4 x;
          x = (u32x4){pk2(p0[0], p0[1]), pk2(p0[2], p0[3]), pk2(p0[4], p0[5]), pk2(p0[6], p0[7])}; pb[0] = __builtin_bit_cast(bf16x8, x);
          x = (u32x4){pk2(p0[8], p0[9]), pk2(p0[10], p0[11]), pk2(p0[12], p0[13]), pk2(p0[14], p0[15])}; pb[1] = __builtin_bit_cast(bf16x8, x);
          x = (u32x4){pk2(p1[0], p1[1]), pk2(p1[2], p1[3]), pk2(p1[4], p1[5]), pk2(p1[6], p1[7])}; pb[2] = __builtin_bit_cast(bf16x8, x);
          x = (u32x4){pk2(p1[8], p1[9]), pk2(p1[10], p1[11]), pk2(p1[12], p1[13]), pk2(p1[14], p1[15])}; pb[3] = __builtin_bit_cast(bf16x8, x); }
#pragma unroll
        for (int ks = 0; ks < 4; ++ks) { O0 = MFMA32(va[0][ks], pb[ks], O0); O1 = MFMA32(va[1][ks], pb[ks], O1); }
    }
    const float lt = lsum + shx(lsum, 32, lane);
    if (r < 16) {
        const float inv = 1.0f / lt;
        bf16* dst = (bf16*)(p.ws + WS_XN) + (size_t)qrow * DM + (MLA ? 0 : 640) + h * 64 + 4 * h2;
#pragma unroll
        for (int g = 0; g < 4; ++g) {
            *(u32x2*)(dst + 8 * g) = (u32x2){pk2(O0[4 * g] * inv, O0[4 * g + 1] * inv), pk2(O0[4 * g + 2] * inv, O0[4 * g + 3] * inv)};
            *(u32x2*)(dst + 32 + 8 * g) = (u32x2){pk2(O1[4 * g] * inv, O1[4 * g + 1] * inv), pk2(O1[4 * g + 2] * inv, O1[4 * g + 3] * inv)};
        }
    }
}
template <bool MLA>
DI void attn_sample_item(const Params& p, LAS unsigned char* lds, int l, int item) {
    int tid_o = threadIdx.x; asm volatile("" : "+v"(tid_o)); const int tid = tid_o, lane = tid & 63, w = __builtin_amdgcn_readfirstlane(tid >> 6);
    LAS float* tabs = (LAS float*)lds;
    if (!MLA) { for (int i = tid; i < 6 * 257; i += 512) { const int hh = i / 257, e = i % 257; tabs[i] = p.in[I_RELB][(size_t)l * 257 * 6 + e * 6 + hh] * LOG2E; } __syncthreads(); }
    const int unit = 8 * item + w;
    attn_sample_wave<MLA>(p, tabs, l, unit / 6, unit % 6, lane);
}

#define XB_TMO      128
#define XB_XCNT(j)  (256  + 64 * (j))
#define XB_XSUB(j)  (1280 + 64 * (j))
#define XB_XGEN(j)  (2304 + 64 * (j))
#define XB_TOP      3328
#define XB_TOPGEN   3392
#define XCD_BAR_WORDS 3456
#define XB_SPIN_CAP (1u << 18)

__device__ __forceinline__ unsigned xb_ld(unsigned* p)              { return __hip_atomic_load(p, __ATOMIC_RELAXED, __HIP_MEMORY_SCOPE_AGENT); }
__device__ __forceinline__ unsigned xb_add(unsigned* p, unsigned v) { return __hip_atomic_fetch_add(p, v, __ATOMIC_RELAXED, __HIP_MEMORY_SCOPE_AGENT); }
__device__ __forceinline__ unsigned xb_xcc_id() { return (unsigned)__builtin_amdgcn_s_getreg((3 << 11) | 20) & 0xFu; }
#define XB_SPIN(cond, bar) do { unsigned _sp = 0; while (cond) { __builtin_amdgcn_s_sleep(1); \
    if ((++_sp & 255u) == 0u) { if (xb_ld(&(bar)[XB_TMO])) break; if (_sp > XB_SPIN_CAP) { atomicAdd(&(bar)[XB_TMO], 1u); break; } } } } while (0)

struct XcdBarrier {
    unsigned* bar; unsigned x;
    volatile LAS unsigned* st;
};

__device__ __forceinline__ XcdBarrier xcd_barrier_post(unsigned* bar, volatile LAS unsigned* st) {
    XcdBarrier b; b.bar = bar; b.x = xb_xcc_id(); b.st = st;
    if (threadIdx.x == 0) (void)xb_add(&bar[XB_XCNT(b.x)], 1u);
    return b;
}
__device__ __forceinline__ void xcd_barrier_complete(unsigned* bar, unsigned x, unsigned& nloc, unsigned& nx) {
    const unsigned G = gridDim.x * gridDim.y * gridDim.z;
    unsigned sum, cnt, mine, sp = 0u;
    for (;;) {
        sum = 0u; cnt = 0u; mine = 0u;
#pragma unroll
        for (unsigned j = 0; j < 16; ++j) { const unsigned c = xb_ld(&bar[XB_XCNT(j)]); sum += c; cnt += (c > 0u) ? 1u : 0u; mine = (j == x) ? c : mine; }
        if (sum == G) break;
        __builtin_amdgcn_s_sleep(1);
        if ((++sp & 255u) == 0u) { if (xb_ld(&bar[XB_TMO])) break; if (sp > XB_SPIN_CAP) { atomicAdd(&bar[XB_TMO], 1u); break; } }
    }
    nloc = mine > 0u ? mine : 1u; nx = cnt > 0u ? cnt : 1u;
}

__device__ __forceinline__ void xcd_barrier(const XcdBarrier& b) {
    asm volatile("s_waitcnt vmcnt(0)" ::: "memory");
    __syncthreads();
    if (threadIdx.x == 0) {
        unsigned* bar = b.bar;
        __builtin_amdgcn_s_waitcnt(0);
        unsigned nloc = b.st[0], nx = b.st[1];
        if (nloc == 0u) { xcd_barrier_complete(bar, b.x, nloc, nx); b.st[0] = nloc; b.st[1] = nx; }
        const unsigned old = xb_add(&bar[XB_XSUB(b.x)], 1u);
        const unsigned gen = old / nloc;
        if (old + 1u == (gen + 1u) * nloc) {
            __builtin_amdgcn_fence(__ATOMIC_RELEASE, "agent");
            asm volatile("s_waitcnt vmcnt(0)" ::: "memory");
            const unsigned og = xb_add(&bar[XB_TOP], 1u);
            const unsigned tg = og / nx;
            if (og + 1u == (tg + 1u) * nx) xb_add(&bar[XB_TOPGEN], 1u);
            else XB_SPIN(xb_ld(&bar[XB_TOPGEN]) == tg, bar);
            __builtin_amdgcn_fence(__ATOMIC_ACQUIRE, "agent");
            xb_add(&bar[XB_XGEN(b.x)], 1u);
            asm volatile("s_waitcnt vmcnt(0)" ::: "memory");
        } else {
            XB_SPIN(xb_ld(&bar[XB_XGEN(b.x)]) == gen, bar);
            __builtin_amdgcn_fence(__ATOMIC_ACQUIRE, "agent");
            asm volatile("s_waitcnt vmcnt(0)" ::: "memory");
        }
    }
    __syncthreads();
}

#ifndef PHMASK
#define PHMASK 0x3ff
#endif
#define ON(k) ((PHMASK >> (k)) & 1)
#ifndef UMASK
#define UMASK 0x3f
#endif
#define UON(k) ((UMASK >> (k)) & 1)
#ifndef DUPMASK
#define DUPMASK 0
#endif
#define DUP(k) ((DUPMASK >> (k)) & 1)
__global__ void __launch_bounds__(512) mega_fwd(Params p_arg) {
    extern __shared__ __attribute__((aligned(16))) unsigned char lds_raw[];
    LAS unsigned char* lds = (LAS unsigned char*)lds_raw;
    cg::grid_group grid = cg::this_grid();
    const int ph_lo = p_arg.ph_lo, ph_hi = p_arg.ph_hi;
    volatile LAS unsigned* MISC = (volatile LAS unsigned*)(lds + LDS_MISC);
    if (threadIdx.x < 32) MISC[threadIdx.x] = 0u;
    __syncthreads();
    const XcdBarrier bar = xcd_barrier_post((unsigned*)(p_arg.ws + WS_CTL) + 4096, MISC + 8);
#define GRID_BAR() xcd_barrier(bar)
#pragma unroll 1
    for (int ph = ph_lo; ph < ph_hi; ++ph) {
#if defined(__HIP_DEVICE_COMPILE__)
        typedef __attribute__((address_space(4))) const Params* KP;
        KP kp = (KP)__builtin_amdgcn_kernarg_segment_ptr(); asm volatile("" : "+s"(kp));
        const Params p = *kp;
#else
        const Params p = p_arg;
#endif
        int l = ph / 9, k = ph - 9 * l;
        asm volatile("" : "+s"(l), "+s"(k));
        const int nrep = 1 + ((l < 2) ? ((DUPMASK >> k) & 1) : 0);
#pragma unroll 1
        for (int rep = 0; rep < nrep; ++rep) {
        if (rep > 0) GRID_BAR();
        unsigned char* ws = p.ws; asm volatile("" : "+s"(ws));
        const size_t wofs = (l == 1) ? WS_W1OFS : 0;
        if (l == 2) { if (ON(9)) phase_rms(p, p.in[I_FNORM], true, 16, lds); }
        else if (k == 0) { if (ON(0)) { if (l == 0) phase_weights(p, 0, lds, 0, gridDim.x); phase_P(p, l, lds); if (l == 1) phase_rms(p, p.in[I_NORM1] + DM, false, rep > 0 ? 0 : 16, lds); } }
        else if (k == 1 || k == 3) {
            const int nd = (k == 1) ? 1 : 3;
            if (ON(1) || ON(3)) {
#pragma unroll 1
            for (int d = 0; d < nd; ++d) {
                pg8::Gemm g; pg8::EpiStore<0> E;
                if (k == 1) { g = pg8::Gemm{(const bf16*)(ws + WS_XN), (const bf16*)(ws + wofs + WS_WIN), MT, 2816, 1024}; E = pg8::EpiStore<0>{(bf16*)(ws + WS_Z), DIN, DIN, MT}; }
                else if (d == 0) { g = pg8::Gemm{(const bf16*)(ws + WS_QN), (const bf16*)(ws + wofs + WS_WQ), MT, 768, 256}; E = pg8::EpiStore<0>{(bf16*)(ws + WS_QM), 576, 576, MT}; }
                else if (d == 1) { g = pg8::Gemm{(const bf16*)(ws + WS_CKV), (const bf16*)(ws + wofs + WS_WK), RALL, 512, 128}; E = pg8::EpiStore<0>{(bf16*)(ws + WS_KN), 384, 384, RALL}; }
                else { g = pg8::Gemm{(const bf16*)(ws + wofs + WS_WV), (const bf16*)(ws + WS_CKV), 512, RALL, 128}; E = pg8::EpiStore<0>{(bf16*)(ws + WS_VT), RALL, RALL, 384}; }
                const int G_ = (int)gridDim.x; const int crot = (k == 1) ? (int)blockIdx.x : (d == 0 ? (int)blockIdx.x : (d == 1 ? ((int)blockIdx.x + 58) % G_ : ((int)blockIdx.x + 182) % G_));
                pg8::StaticOrder S; S.init(g.M, g.N, gridDim.x, crot);
                pg8::gemm_phase<pg8::EpiStore<0>, pg8::StaticOrder, true, true>(lds, g, S, E);
            }
            if (k == 3) gla_scan(p, l);
            }
        }
        else if (k == 2) {
            if (ON(2)) {
            int tid_o = threadIdx.x; asm volatile("" : "+v"(tid_o)); const int lane = tid_o & 63, wave = tid_o >> 6;
            {
                const int gw = blockIdx.x * 8 + wave, NGW = gridDim.x * 8;
                for (int r0 = gw; r0 < MT; r0 += 4 * NGW) token_part<4>(p, l, r0, NGW, lane);
                for (int j = NGW - 1 - gw; j < 1536; j += NGW) cakv_row_out(p, l, j, lane);
                for (int u = blockIdx.x; u < 256; u += gridDim.x) gla_u_unit(p, lds, l, u >> 7, u & 127);
            }
            }
        }
        else if (k == 4) {
            if (ON(4)) {
            int tid_o = threadIdx.x; asm volatile("" : "+v"(tid_o)); const int tid = tid_o;
            unsigned* ctr = (unsigned*)(ws + WS_CTL) + 64 * l + 256 * rep;
            LAS unsigned* slot = (LAS unsigned*)(lds + LDS_MISC);
            for (;;) {
                __syncthreads();
                if (tid == 0) *slot = atomicAdd(ctr, 1u);
                __syncthreads();
                int u = (int)*slot;
#ifdef DUPU
                {
                    constexpr int lo_[6] = {80, 464, 720, 0, 24, 48}, hi_[6] = {464, 720, 1104, 24, 48, 80};
                    if (u >= 1104 + (hi_[DUPU] - lo_[DUPU])) break;
                    if (u >= 1104) u = lo_[DUPU] + (u - 1104);
                }
#else
                if (u >= 1104) break;
#endif
                if (UON(3) && u < 24) { attn_sample_item<true>(p, lds, l, u); }
                else if (UON(4) && u < 48) { attn_sample_item<false>(p, lds, l, u - 24); }
                else if (UON(5) && u < 80) { gla_o_unit<true>(p, lds, l, u - 48, 0); }
                else if (UON(0) && u < 464) { const int v = u - 80; const int qb = 31 - v / 12, bh = v % 12; attn_unit<0>(p, lds, l, bh / 6, bh % 6, qb); }
                else if (UON(1) && u < 720) { const int v = u - 464; gla_o_unit<false>(p, lds, l, v >> 7, v & 127); }
                else if (UON(2)) { const int v = u - 720; const int qb = 31 - v / 12, bh = v % 12; attn_unit<1>(p, lds, l, bh / 6, bh % 6, qb); }
            }
            }
        }
        else if (k == 5 || k == 8) {
            if (ON(5) || ON(8)) {
            const bf16* A = (k == 5) ? (const bf16*)(ws + WS_XN) : (const bf16*)(ws + WS_H); const bf16* W = (k == 5) ? (const bf16*)(ws + wofs + WS_WO) : (const bf16*)(ws + wofs + WS_WDN);
            const int K = (k == 5) ? 1024 : DFF;
            {
                pg8::Gemm g{A, W, MP, 1024, K, K}; pg8::StaticOrder S; S.init(MP, 1024, gridDim.x, blockIdx.x);
                pg8::EpiResidual E{(k == 5 && l == 0) ? p.in[I_XP] : (const float*)p.out, p.out, DM};
                pg8::gemm_phase<pg8::EpiResidual, pg8::StaticOrder, true, true>(lds, g, S, E); }
            {
                const int nS = (k == 5) ? 8 : 16;
                pg8::Gemm g{A + (size_t)MP * K, W, MS, 1024, K / nS, K}; pg8::SplitOrder S; S.init(MS, 1024, nS, gridDim.x, blockIdx.x);
                pg8::EpiPartial E{(float*)(ws + WS_PART), DM, (size_t)MS * DM};
                pg8::gemm_phase<pg8::EpiPartial, pg8::SplitOrder, false, false>(lds, g, S, E); }
            }
        }
        else if (k == 6) { if (ON(6)) phase_rms(p, p.in[I_NORM2] + l * DM, false, rep > 0 ? 0 : 8, lds); }
        else {
            if (ON(7)) {
            pg8::Gemm g{(const bf16*)(ws + WS_XN), (const bf16*)(ws + wofs + WS_WUP), MT, DFF, 1024}; pg8::StaticOrder S; S.init(MT, DFF, gridDim.x, blockIdx.x);
            pg8::EpiStore<1> E{(bf16*)(ws + WS_H), DFF, DFF, MT};
            pg8::gemm_phase<pg8::EpiStore<1>, pg8::StaticOrder, true, true>(lds, g, S, E);
            if (l == 0) { if (gridDim.x > 64) phase_weights(p, 1, lds, 32, gridDim.x - 32); else phase_weights(p, 1, lds, 0, gridDim.x); }
            }
        }
        }
        if (ph + 1 < ph_hi) { if (ph_lo < 0) grid.sync(); else GRID_BAR(); }
#ifdef EXTRA_SYNCS
        for (int q = 0; q < EXTRA_SYNCS; ++q) GRID_BAR();
#endif
    }
}
constexpr int N_PHASES = 19;

#ifndef N_LAUNCH_SPLIT
#define N_LAUNCH_SPLIT 0
#endif
extern "C" void kernel_launch(void* const* d_in, const int* in_sizes, int n_in, void* d_out, int out_size, void* d_ws, size_t ws_size, hipStream_t stream) {
    static int grid = 0;
    if (grid == 0) {
        if (n_in != 22 || out_size != (int)O_END || ws_size < WS_NEED) { fprintf(stderr, "kernel_launch: unexpected shapes (n_in %d out %d ws %zu need %zu)\n", n_in, out_size, ws_size, (size_t)WS_NEED); grid = -1; return; }
        int dev = 0, cus = 0, per_cu = 0;
        hipGetDevice(&dev); hipDeviceGetAttribute(&cus, hipDeviceAttributeMultiprocessorCount, dev);
        hipFuncSetAttribute((const void*)mega_fwd, hipFuncAttributeMaxDynamicSharedMemorySize, LDS_BYTES);
        hipOccupancyMaxActiveBlocksPerMultiprocessor(&per_cu, (const void*)mega_fwd, 512, LDS_BYTES);
        if (per_cu < 1) { fprintf(stderr, "kernel_launch: occupancy query says %d blocks per CU\n", per_cu); per_cu = 1; }
        (void)hipGetLastError();
        grid = cus;
    }
    if (grid < 0) return;
    hipMemsetAsync((char*)d_ws + WS_CTL, 0, 32768, stream);
    Params prm{};
    for (int i = 0; i < 22; ++i) prm.in[i] = (const float*)d_in[i];
    prm.out = (float*)d_out; prm.ws = (unsigned char*)d_ws;
#if N_LAUNCH_SPLIT
    for (int i = 0; i < N_PHASES; ++i) { prm.ph_lo = i; prm.ph_hi = i + 1; void* args[] = {&prm};
        hipLaunchCooperativeKernel((const void*)mega_fwd, dim3(grid), dim3(512), args, LDS_BYTES, stream); }
#else
    prm.ph_lo = 0; prm.ph_hi = N_PHASES; void* args[] = {&prm};
    hipError_t e = hipLaunchCooperativeKernel((const void*)mega_fwd, dim3(grid), dim3(512), args, LDS_BYTES, stream);
    if (e != hipSuccess) fprintf(stderr, "cooperative launch failed: %s (grid %d)\n", hipGetErrorString(e), grid);
#endif
}
```

```cpp
#include <hip/hip_runtime.h>
#include <hip/hip_cooperative_groups.h>
#include <cstdio>
#include <cstdint>
namespace cg = cooperative_groups;
namespace pg8 {
#define PG8_LAS __attribute__((address_space(3)))
typedef unsigned short bf16_t;
typedef short bf16x8 __attribute__((ext_vector_type(8)));
typedef float f32x4 __attribute__((ext_vector_type(4)));
typedef unsigned u32x4 __attribute__((ext_vector_type(4)));
constexpr int BM = 256, BK = 64, HALF = 128, HTB = HALF * BK * 2  , STAGE_BYTES = 8 * HTB, NXCD = 8, WGM = 8;

__host__ __device__ __forceinline__ int lds_byte(int r, int c) { const int st = (r >> 4) * 2 + (c >> 5), rr = r & 15, cc = c & 31, ob = rr * 64 + cc * 2; return st * 1024 + (ob ^ (((ob >> 9) & 1) << 5)); }
__host__ __device__ __forceinline__ void stage_rc(int b, int& R, int& C) { const int st = b / 1024, sb = b % 1024, swz = sb ^ (((sb >> 9) & 1) << 5); R = (st >> 1) * 16 + swz / 64; C = (st & 1) * 32 + (swz % 64) / 2; }
__host__ __device__ __forceinline__ int perm32(int rho) { const int n = rho >> 4, i = rho & 15; return 8 * (i >> 2) + 4 * n + (i & 3); }

struct Unit { int pm, pn, ks; };
struct Gemm { const bf16_t* A; const bf16_t* Bt; int M, N, K, ld; };

struct StaticOrder {
    int nM, nN, nwg, G, c;
    __host__ __device__ void init(int M, int N, int G_, int c_) { nM = M / BM; nN = N / BM; nwg = nM * nN; G = G_; c = c_; }
    __host__ __device__ bool next(int i, Unit& u) const {
        const long L = (long)i * G + c; if (L >= nwg) return false;
        int wgid = (int)L; { const int q = nwg / NXCD, r = nwg % NXCD, xcd = wgid % NXCD, off = wgid / NXCD; wgid = (xcd < r ? xcd * (q + 1) : r * (q + 1) + (xcd - r) * q) + off; }
        const int nig = WGM * nN, gid = wgid / nig, fm = gid * WGM, gsz = (nM - fm) < WGM ? (nM - fm) : WGM;
        u.pm = fm + ((wgid % nig) % gsz); u.pn = (wgid % nig) / gsz; u.ks = 0; return true;
    }
    __device__ __forceinline__ void a_ready(const Unit&) const {}
    __device__ __forceinline__ void done(const Unit&) const {}
};

struct SplitOrder {
    int nM, nN, nS, G, c;
    __host__ __device__ void init(int M, int N, int nS_, int G_, int c_) { nM = M / BM; nN = N / BM; nS = nS_; G = G_; c = c_; }
    __host__ __device__ bool next(int i, Unit& u) const {
        const long L = (long)i * G + c; if (L >= (long)nM * nN * nS) return false;
        const int r = (int)L; u.ks = r % nS; const int t = r / nS; u.pn = t % nN; u.pm = t / nN; return true;
    }
    __device__ __forceinline__ void a_ready(const Unit&) const {}
    __device__ __forceinline__ void done(const Unit&) const {}
};
typedef float f32x2_t __attribute__((ext_vector_type(2))); typedef __bf16 bf16x2_t __attribute__((ext_vector_type(2)));
__device__ __forceinline__ unsigned cvt_pk_bf16(float lo, float hi) { f32x2_t v = {lo, hi}; bf16x2_t b = __builtin_convertvector(v, bf16x2_t); return __builtin_bit_cast(unsigned, b); }
template <int ACT  > struct EpiStore {
    static constexpr bool PERM = true, AFTER_DRAIN = false;
    bf16_t* O; int ldc; int ncols; int nrows;
    __device__ __forceinline__ void operator()(const f32x4 (&acc)[2][2][4][2], const Unit& u, int wr, int wc, int fr, int fq) const {
        const int row0 = u.pm * BM + wr * 64 + fr; const int col0 = u.pn * BM + wc * 32 + 8 * fq;
#pragma unroll
        for (int ai = 0; ai < 2; ++ai)
#pragma unroll
            for (int m = 0; m < 4; ++m) { const int row = row0 + ai * HALF + m * 16; if (row >= nrows) continue;
                bf16_t* rowp = O + (size_t)row * ldc;
#pragma unroll
                for (int bj = 0; bj < 2; ++bj) { const int col = col0 + bj * HALF; if (col >= ncols) continue;
                    f32x4 v0 = acc[ai][bj][m][0], v1 = acc[ai][bj][m][1];
                    if (ACT == 1) {
#pragma unroll
                        for (int e = 0; e < 4; ++e) { float a = v0[e] > 0.f ? v0[e] : 0.f; v0[e] = a * a; float b = v1[e] > 0.f ? v1[e] : 0.f; v1[e] = b * b; } }
                    u32x4 w; w.x = cvt_pk_bf16(v0[0], v0[1]); w.y = cvt_pk_bf16(v0[2], v0[3]); w.z = cvt_pk_bf16(v1[0], v1[1]); w.w = cvt_pk_bf16(v1[2], v1[3]);
                    *(u32x4*)(rowp + col) = w; } }
    }
};
struct EpiResidual {
    static constexpr bool PERM = true, AFTER_DRAIN = false;
    const float* B; float* X; int ldc;
    __device__ __forceinline__ void operator()(const f32x4 (&acc)[2][2][4][2], const Unit& u, int wr, int wc, int fr, int fq) const {
        const int row0 = u.pm * BM + wr * 64 + fr; const int col0 = u.pn * BM + wc * 32 + 8 * fq;
#pragma unroll
        for (int ai = 0; ai < 2; ++ai)
#pragma unroll
            for (int m = 0; m < 4; ++m) { const size_t off = (size_t)(row0 + ai * HALF + m * 16) * ldc + col0; const float* bp = B + off; float* rowp = X + off;
#pragma unroll
                for (int bj = 0; bj < 2; ++bj) {
                    f32x4 x0 = *(const f32x4*)(bp + bj * HALF), x1 = *(const f32x4*)(bp + bj * HALF + 4);
                    x0 = x0 + acc[ai][bj][m][0]; x1 = x1 + acc[ai][bj][m][1];
                    *(f32x4*)(rowp + bj * HALF) = x0; *(f32x4*)(rowp + bj * HALF + 4) = x1; }
                asm volatile("" ::: "memory"); }
    }
};
struct EpiPartial {
    static constexpr bool PERM = true, AFTER_DRAIN = false;
    float* P; int ldc; size_t sstride;
    __device__ __forceinline__ void operator()(const f32x4 (&acc)[2][2][4][2], const Unit& u, int wr, int wc, int fr, int fq) const {
        const int row0 = u.pm * BM + wr * 64 + fr; const int col0 = u.pn * BM + wc * 32 + 8 * fq;
        float* base = P + (size_t)u.ks * sstride;
#pragma unroll
        for (int ai = 0; ai < 2; ++ai)
#pragma unroll
            for (int m = 0; m < 4; ++m) { float* rowp = base + (size_t)(row0 + ai * HALF + m * 16) * ldc + col0;
#pragma unroll
                for (int bj = 0; bj < 2; ++bj) { *(f32x4*)(rowp + bj * HALF) = acc[ai][bj][m][0]; *(f32x4*)(rowp + bj * HALF + 4) = acc[ai][bj][m][1]; } }
    }
};
template <class Epi, class Sched, bool ALIGN_EPI = false, bool SP2 = false>
__device__ __forceinline__ void gemm_phase(PG8_LAS unsigned char* lds, const Gemm g, const Sched& S, const Epi& E) {
    int tid_o = threadIdx.x; asm volatile("" : "+v"(tid_o)); const int tid = tid_o, wid = __builtin_amdgcn_readfirstlane(tid >> 6), lane = tid & 63, wr = wid >> 2, wc = wid & 3, fr = lane & 15, fq = lane >> 4;
    const int K = g.K, nt = K / BK, LD = g.ld ? g.ld : g.K;
    unsigned voffA[2], voffB[2];
#pragma unroll
    for (int i = 0; i < 2; ++i) { int R, C; stage_rc(tid * 16 + i * 8192, R, C); const int Rb = Epi::PERM ? ((R & ~31) + perm32(R & 31)) : R;
        voffA[i] = (unsigned)(R * LD + C) * 2u; voffB[i] = (unsigned)(Rb * LD + C) * 2u; }
    const size_t kstep = (size_t)(BK * 2);
    const size_t hstep = (size_t)HALF * LD * 2;
    const size_t tstep = 2 * hstep;
    const unsigned ldsw = (unsigned)wid * 1024u;
    const int aoff = lds_byte(wr * 64 + fr, fq * 8), boff = lds_byte(wc * 32 + fr, fq * 8);
#define PG8_SA(b, h) (((b) * 2 + (h)) * HTB)
#define PG8_SB(b, h) ((4 + (b) * 2 + (h)) * HTB)
#define PG8_STAGE(bufoff, gbase, voff) do { _Pragma("unroll") for (int _i = 0; _i < 2; ++_i) \
        __builtin_amdgcn_global_load_lds((const unsigned*)((const char*)(gbase) + (voff)[_i]), (PG8_LAS unsigned*)(lds + (bufoff) + ldsw + _i * 8192), 16, 0, 0); } while (0)
#define PG8_LDA(dst, b, h) do { _Pragma("unroll") for (int m = 0; m < 4; ++m) _Pragma("unroll") for (int k = 0; k < 2; ++k) dst[m][k] = *(const PG8_LAS bf16x8*)(lds + PG8_SA(b, h) + aoff + m * 2048 + k * 1024); } while (0)
#define PG8_LDB(dst, b, h) do { _Pragma("unroll") for (int n = 0; n < 2; ++n) _Pragma("unroll") for (int k = 0; k < 2; ++k) dst[n][k] = *(const PG8_LAS bf16x8*)(lds + PG8_SB(b, h) + boff + n * 2048 + k * 1024); } while (0)
#define PG8_MMA(ai, bj, At, Bt) do { __builtin_amdgcn_s_setprio(1); _Pragma("unroll") for (int m = 0; m < 4; ++m) _Pragma("unroll") for (int n = 0; n < 2; ++n) _Pragma("unroll") for (int k = 0; k < 2; ++k) \
        acc[ai][bj][m][n] = __builtin_amdgcn_mfma_f32_16x16x32_bf16(Bt[n][k], At[m][k], acc[ai][bj][m][n], 0, 0, 0); __builtin_amdgcn_s_setprio(0); } while (0)
#define PG8_WAIT_V(n) asm volatile("s_waitcnt vmcnt(" #n ")" ::: "memory")
#define PG8_WAIT_L(n) asm volatile("s_waitcnt lgkmcnt(" #n ")" ::: "memory")
#define PG8_BAR __builtin_amdgcn_s_barrier()
#define PG8_SCHED __builtin_amdgcn_sched_barrier(0)
    Unit cur, nxt; int ui = 0;
    if (!S.next(0, cur)) return;
    f32x4 acc[2][2][4][2];
#pragma unroll
    for (int a = 0; a < 2; ++a)
#pragma unroll
        for (int b = 0; b < 2; ++b)
#pragma unroll
            for (int m = 0; m < 4; ++m)
#pragma unroll
                for (int n = 0; n < 2; ++n) acc[a][b][m][n] = (f32x4){0.f, 0.f, 0.f, 0.f};
    bf16x8 At[4][2], B0[2][2], B1[2][2];
    const char* cA = (const char*)g.A + (size_t)cur.pm * tstep + (size_t)cur.ks * K * 2; const char* cB = (const char*)g.Bt + (size_t)cur.pn * tstep + (size_t)cur.ks * K * 2;
    S.a_ready(cur);
    if constexpr (SP2) {
        PG8_STAGE(PG8_SB(0, 0), cB, voffB); PG8_STAGE(PG8_SB(0, 1), cB + hstep, voffB); PG8_STAGE(PG8_SA(0, 0), cA, voffA); PG8_STAGE(PG8_SA(0, 1), cA + hstep, voffA);
        if (wr == 1) PG8_BAR;
        PG8_WAIT_V(2); PG8_BAR;
        PG8_STAGE(PG8_SB(1, 0), cB + kstep, voffB); PG8_STAGE(PG8_SA(1, 0), cA + kstep, voffA); PG8_STAGE(PG8_SB(1, 1), cB + hstep + kstep, voffB);
        PG8_WAIT_V(6); PG8_BAR;
    } else {
        PG8_STAGE(PG8_SB(0, 0), cB, voffB); PG8_STAGE(PG8_SA(0, 0), cA, voffA); PG8_STAGE(PG8_SB(0, 1), cB + hstep, voffB); PG8_STAGE(PG8_SA(0, 1), cA + hstep, voffA);
        if (wr == 1) PG8_BAR;
        PG8_WAIT_V(4); PG8_BAR;
        PG8_STAGE(PG8_SB(1, 0), cB + kstep, voffB); PG8_STAGE(PG8_SA(1, 0), cA + kstep, voffA); PG8_STAGE(PG8_SB(1, 1), cB + hstep + kstep, voffB);
        PG8_WAIT_V(6); PG8_BAR;
    }
    for (;;) {
        const bool has_next = S.next(ui + 1, nxt);
        const char* nA = has_next ? (const char*)g.A + (size_t)nxt.pm * tstep + (size_t)nxt.ks * K * 2 : cA; const char* nB = has_next ? (const char*)g.Bt + (size_t)nxt.pn * tstep + (size_t)nxt.ks * K * 2 : cB;
        for (int t = 0; t < nt; t += 2) {
            const bool last = (t == nt - 2);
            const char* a1 = cA + (size_t)(t + 1) * kstep;
            const char* a2 = last ? nA : cA + (size_t)(t + 2) * kstep; const char* b2 = last ? nB : cB + (size_t)(t + 2) * kstep;
            const char* a3 = a2 + kstep; const char* b3 = b2 + kstep;
            if (last && has_next) S.a_ready(nxt);
            if constexpr (SP2) {
            PG8_LDB(B0, 0, 0); PG8_LDB(B1, 0, 1); PG8_SCHED; PG8_LDA(At, 0, 0); PG8_STAGE(PG8_SA(1, 1), a1 + hstep, voffA);
            PG8_WAIT_V(8); PG8_WAIT_L(0); PG8_BAR; PG8_MMA(0, 0, At, B0); PG8_MMA(0, 1, At, B1); PG8_BAR; PG8_SCHED;
            PG8_LDA(At, 0, 1); PG8_STAGE(PG8_SB(0, 0), b2, voffB); PG8_STAGE(PG8_SB(0, 1), b2 + hstep, voffB); PG8_STAGE(PG8_SA(0, 0), a2, voffA);
            PG8_WAIT_V(8); PG8_WAIT_L(0); PG8_BAR; PG8_MMA(1, 0, At, B0); PG8_MMA(1, 1, At, B1); PG8_BAR; PG8_SCHED;
            PG8_LDB(B0, 1, 0); PG8_LDB(B1, 1, 1); PG8_SCHED; PG8_LDA(At, 1, 0); PG8_STAGE(PG8_SA(0, 1), a2 + hstep, voffA);
            PG8_WAIT_V(8); PG8_WAIT_L(0); PG8_BAR; PG8_MMA(0, 0, At, B0); PG8_MMA(0, 1, At, B1); PG8_BAR; PG8_SCHED;
            PG8_LDA(At, 1, 1); PG8_STAGE(PG8_SB(1, 0), b3, voffB); PG8_STAGE(PG8_SB(1, 1), b3 + hstep, voffB); PG8_STAGE(PG8_SA(1, 0), a3, voffA);
            PG8_WAIT_V(8); PG8_WAIT_L(0); PG8_BAR; PG8_MMA(1, 0, At, B0); PG8_MMA(1, 1, At, B1); PG8_BAR; PG8_SCHED;
            } else {
            PG8_LDB(B0, 0, 0); PG8_SCHED; PG8_LDA(At, 0, 0); PG8_STAGE(PG8_SA(1, 1), a1 + hstep, voffA);
            PG8_WAIT_L(8); PG8_BAR; PG8_WAIT_L(0); PG8_MMA(0, 0, At, B0); PG8_BAR; PG8_SCHED;
            PG8_LDB(B1, 0, 1); PG8_STAGE(PG8_SB(0, 0), b2, voffB);
            PG8_BAR; PG8_WAIT_L(0); PG8_MMA(0, 1, At, B1); PG8_BAR;
            PG8_LDA(At, 0, 1); PG8_STAGE(PG8_SA(0, 0), a2, voffA);
            PG8_BAR; PG8_WAIT_L(0); PG8_MMA(1, 0, At, B0); PG8_BAR; PG8_SCHED;
            PG8_STAGE(PG8_SB(0, 1), b2 + hstep, voffB);
            PG8_WAIT_V(6); PG8_BAR; PG8_MMA(1, 1, At, B1); PG8_BAR;
            PG8_LDB(B0, 1, 0); PG8_SCHED; PG8_LDA(At, 1, 0); PG8_STAGE(PG8_SA(0, 1), a2 + hstep, voffA);
            PG8_WAIT_L(8); PG8_BAR; PG8_WAIT_L(0); PG8_MMA(0, 0, At, B0); PG8_BAR; PG8_SCHED;
            PG8_LDB(B1, 1, 1); PG8_STAGE(PG8_SB(1, 0), b3, voffB);
            PG8_BAR; PG8_WAIT_L(0); PG8_MMA(0, 1, At, B1); PG8_BAR;
            PG8_LDA(At, 1, 1); PG8_STAGE(PG8_SA(1, 0), a3, voffA);
            PG8_BAR; PG8_WAIT_L(0); PG8_MMA(1, 0, At, B0); PG8_BAR; PG8_SCHED;
            PG8_STAGE(PG8_SB(1, 1), b3 + hstep, voffB);
            PG8_WAIT_V(6); PG8_BAR; PG8_MMA(1, 1, At, B1); PG8_BAR;
            }
        }
        if constexpr (ALIGN_EPI) { if (wr == 0) PG8_BAR; }
        if constexpr (!Epi::AFTER_DRAIN) { E(acc, cur, wr, wc, fr, fq); S.done(cur); }
        if (!has_next) break;
#pragma unroll
        for (int a = 0; a < 2; ++a)
#pragma unroll
            for (int b = 0; b < 2; ++b)
#pragma unroll
                for (int m = 0; m < 4; ++m)
#pragma unroll
                    for (int n = 0; n < 2; ++n) acc[a][b][m][n] = (f32x4){0.f, 0.f, 0.f, 0.f};
        cur = nxt; cA = nA; cB = nB; ++ui;
        if constexpr (ALIGN_EPI) { if (wr == 1) PG8_BAR; }
    }
    PG8_WAIT_V(0);
    if constexpr (!ALIGN_EPI) { if (wr == 0) PG8_BAR; }
    PG8_BAR;
    if constexpr (Epi::AFTER_DRAIN) { E.fused(acc, cur, wr, wc, fr, fq, lds, wid, lane); S.done(cur); }
#undef PG8_SA
#undef PG8_SB
#undef PG8_STAGE
#undef PG8_LDA
#undef PG8_LDB
#undef PG8_MMA
#undef PG8_WAIT_V
#undef PG8_WAIT_L
#undef PG8_BAR
#undef PG8_SCHED
}
}

#define DI __device__ __forceinline__
#define LAS __attribute__((address_space(3)))
typedef unsigned short bf16;
typedef short bf16x8 __attribute__((ext_vector_type(8)));
typedef short s16x4 __attribute__((ext_vector_type(4)));
typedef float f32x4 __attribute__((ext_vector_type(4)));
typedef float f32x2 __attribute__((ext_vector_type(2)));
typedef float f32x16 __attribute__((ext_vector_type(16)));
typedef unsigned u32x4 __attribute__((ext_vector_type(4)));
typedef unsigned u32x2 __attribute__((ext_vector_type(2)));

constexpr int DM = 1024, SEQ = 8192, NBAT = 2, MP = NBAT * SEQ, DBAT = 32, DSEQ = 16, MS = DBAT * DSEQ, MT = MP + MS, PAST = 1024;
constexpr int RALL = MT + DBAT * PAST;
constexpr int DIN = 2608, DFF = 4096;
constexpr int C_QLAT = 0, C_CKV = 256, C_KR = 384, C_GQ = 416, C_GK = 672, C_GV = 928, C_GLR = 1184, C_GOUT = 1200, C_CQ = 1456, C_CK = 1840, C_CV = 2224;
constexpr float EPS = 1e-6f;
constexpr float LOG2E = 1.4426950408889634f;
constexpr size_t O_Y = 0;
constexpr size_t O_PCKV = (size_t)MT * DM;
constexpr size_t O_PKR = O_PCKV + (size_t)2 * NBAT * SEQ * 128;
constexpr size_t O_PGLA = O_PKR + (size_t)2 * NBAT * SEQ * 32;
constexpr size_t O_PCAK = O_PGLA + (size_t)2 * NBAT * 4 * 64 * 64;
constexpr size_t O_PCAV = O_PCAK + (size_t)2 * NBAT * 512 * 384;
constexpr size_t O_SCKV = O_PCAV + (size_t)2 * NBAT * 512 * 384;
constexpr size_t O_SKR = O_SCKV + (size_t)2 * DBAT * DSEQ * 128;
constexpr size_t O_SGLA = O_SKR + (size_t)2 * DBAT * DSEQ * 32;
constexpr size_t O_SCAK = O_SGLA + (size_t)2 * DBAT * 4 * 64 * 64;
constexpr size_t O_SCAV = O_SCAK + (size_t)2 * DBAT * DSEQ * 384;
constexpr size_t O_END = O_SCAV + (size_t)2 * DBAT * DSEQ * 384;
static_assert(O_END == 26181632, "output size");
constexpr size_t al256(size_t x) { return (x + 255) & ~(size_t)255; }
constexpr size_t WS_CTL = 0;
constexpr size_t WS_WIN = 65536;
constexpr size_t WS_WQ = WS_WIN + (size_t)2816 * 1024 * 2;
constexpr size_t WS_WK = WS_WQ + (size_t)768 * 256 * 2;
constexpr size_t WS_WV = WS_WK + (size_t)512 * 128 * 2;
constexpr size_t WS_WO = WS_WV + (size_t)512 * 128 * 2;
constexpr size_t WS_WUP = WS_WO + (size_t)1024 * 1024 * 2;
constexpr size_t WS_WDN = WS_WUP + (size_t)4096 * 1024 * 2;
constexpr size_t WS_XN = WS_WDN + (size_t)1024 * 4096 * 2;
constexpr size_t WS_QN = WS_XN + (size_t)MT * 1024 * 2;
constexpr size_t WS_CKV = WS_QN + (size_t)MT * 256 * 2;
constexpr size_t WS_KR = WS_CKV + (size_t)RALL * 128 * 2;
constexpr size_t WS_GU = WS_KR + (size_t)RALL * 32 * 2;
constexpr size_t WS_GA = WS_GU + (size_t)1024 * 4096 * 4;
constexpr size_t WS_Z = WS_GA + (size_t)1024 * 64 * 4;
constexpr size_t WS_QM = WS_Z + (size_t)MT * DIN * 2;
constexpr size_t WS_KN = WS_QM + (size_t)MT * 576 * 2;
constexpr size_t WS_VT = WS_KN + (size_t)RALL * 384 * 2;
constexpr size_t WS_END0 = WS_VT + (size_t)384 * RALL * 2;
constexpr size_t WS_H = WS_Z;
static_assert(WS_H + (size_t)MT * DFF * 2 <= WS_END0, "H overlay");
constexpr size_t WS_PART = WS_H + (size_t)MT * DFF * 2;
static_assert(WS_PART + (size_t)16 * MS * DM * 4 <= WS_END0, "partials");
constexpr size_t WS_W1OFS = WS_END0 - WS_WIN;
constexpr size_t WS_NEED = WS_END0 + (WS_XN - WS_WIN);
static_assert(WS_NEED <= 314907696ull, "ws budget");
static_assert(WS_XN % 256 == 0 && WS_Z % 256 == 0 && WS_QM % 256 == 0 && WS_KN % 256 == 0 && WS_VT % 256 == 0 && WS_CKV % 256 == 0, "align");

constexpr int LDS_BYTES = 147456;
constexpr int LDS_MISC = 131072;

struct Params { const float* in[22]; float* out; unsigned char* ws; int ph_lo, ph_hi; };
enum { I_XP = 0, I_XS, I_CCKV, I_CKR, I_SGLA, I_CCAK, I_CCAV, I_NORM1, I_WIN, I_QNORM, I_WQUP, I_KVNORM, I_WKVUP, I_WG2, I_GBIAS, I_GONORM, I_RELB, I_WOUT, I_NORM2, I_WUP, I_WDN, I_FNORM };

DI float bf2f(bf16 u) { return __uint_as_float((unsigned)u << 16); }
typedef __bf16 bf16x2_t __attribute__((ext_vector_type(2)));
DI unsigned pk2(float lo, float hi) { f32x2 v = {lo, hi}; bf16x2_t b = __builtin_convertvector(v, bf16x2_t); return __builtin_bit_cast(unsigned, b); }
DI bf16 f2bf(float f) { return (bf16)(pk2(f, 0.f) & 0xffffu); }
DI float shx(float v, int o, int lane) { return __int_as_float(__builtin_amdgcn_ds_bpermute((lane ^ o) << 2, __float_as_int(v))); }
DI float wave_sum(float v, int lane) {
#pragma unroll
    for (int o = 1; o < 64; o <<= 1) v += shx(v, o, lane);
    return v;
}
DI int crow(int i, int h2) { return (i & 3) + 8 * (i >> 2) + 4 * h2; }
#define MFMA32(a, b, c) __builtin_amdgcn_mfma_f32_32x32x16_bf16((a), (b), (c), 0, 0, 0)
DI void sincos_pos(float ang, float& s, float& c) {
    const double rev = (double)ang * 0.15915494309189535; const float f = (float)(rev - floor(rev));
    s = __builtin_amdgcn_sinf(f); c = __builtin_amdgcn_cosf(f);
}
DI float rope_inv(int i) { return exp2f(-(float)i * (13.287712379549449f / 16.0f)); }

DI void transpose_item(const float* W, int K, int N, bf16* dst, int k0, int n0, LAS float* scr, int lane) {
    const int nc = n0 + (lane & 31); const bool ok = nc < N;
    float wv[32];
#pragma unroll
    for (int i = 0; i < 32; ++i) { const int kk = 2 * i + (lane >> 5); wv[i] = ok ? __builtin_nontemporal_load(W + (size_t)(k0 + kk) * N + nc) : 0.f; }
#pragma unroll
    for (int i = 0; i < 32; ++i) { const int kk = 2 * i + (lane >> 5); scr[kk * 33 + (lane & 31)] = wv[i]; }
    asm volatile("s_waitcnt lgkmcnt(0)" ::: "memory");
    const int c = lane & 7;
#pragma unroll
    for (int j = 0; j < 4; ++j) { const int n = (lane >> 3) + 8 * j; const LAS float* s = scr + (8 * c) * 33 + n;
        u32x4 o; o.x = pk2(s[0 * 33], s[1 * 33]); o.y = pk2(s[2 * 33], s[3 * 33]); o.z = pk2(s[4 * 33], s[5 * 33]); o.w = pk2(s[6 * 33], s[7 * 33]);
        *(u32x4*)(dst + (size_t)n * K + k0 + 8 * c) = o; }
    asm volatile("s_waitcnt lgkmcnt(0)" ::: "memory");
}
DI void rms_row(const float* xrow, const float* g, bf16* orow, float* xcopy, int lane) {
    f32x4 v[4]; float s = 0.f;
#pragma unroll
    for (int j = 0; j < 4; ++j) { v[j] = *(const f32x4*)(xrow + 256 * j + 4 * lane); s += (v[j].x * v[j].x + v[j].y * v[j].y) + (v[j].z * v[j].z + v[j].w * v[j].w); }
    const float rstd = 1.0f / sqrtf(wave_sum(s, lane) * (1.f / 1024.f) + EPS);
#pragma unroll
    for (int j = 0; j < 4; ++j) { const f32x4 gg = *(const f32x4*)(g + 256 * j + 4 * lane);
        if (xcopy) *(f32x4*)(xcopy + 256 * j + 4 * lane) = v[j];
        u32x2 o; o.x = pk2(v[j].x * rstd * gg.x, v[j].y * rstd * gg.y); o.y = pk2(v[j].z * rstd * gg.z, v[j].w * rstd * gg.w);
        *(u32x2*)(orow + 256 * j + 4 * lane) = o; }
}
DI void phase_weights(const Params& p, int l, LAS unsigned char* lds, int wg0, int nwg) {
    int tid_o = threadIdx.x; asm volatile("" : "+v"(tid_o)); const int tid = tid_o, lane = tid & 63, wave = tid >> 6;
    const int gw = ((int)blockIdx.x - wg0) * 8 + wave, NGW = nwg * 8;
    if ((int)blockIdx.x < wg0 || (int)blockIdx.x >= wg0 + nwg) return;
    LAS float* scr = (LAS float*)(lds + wave * 16384);
    unsigned char* ws = p.ws + (l ? WS_W1OFS : 0);
    bf16* Win_t = (bf16*)(ws + WS_WIN); bf16* Wq_t = (bf16*)(ws + WS_WQ); bf16* Wk_t = (bf16*)(ws + WS_WK); bf16* Wv_t = (bf16*)(ws + WS_WV);
    bf16* Wo_t = (bf16*)(ws + WS_WO); bf16* Wup_t = (bf16*)(ws + WS_WUP); bf16* Wdn_t = (bf16*)(ws + WS_WDN);
    constexpr int I_IN = 16 * 88, I_Q = 4 * 24, I_KV = 2 * 24, I_O = 16 * 32, I_UP = 16 * 128, I_DN = 64 * 32, I_ZP = 64;
    constexpr int NIT = I_IN + I_Q + I_KV + I_O + I_UP + I_DN + I_ZP;
    for (int it = gw; it < NIT; it += NGW) {
        int r = it;
        if (r < I_IN) { const int kb = r / 88, nb = r % 88; transpose_item(p.in[I_WIN] + (size_t)l * 1024 * DIN, 1024, DIN, Win_t + (size_t)(32 * nb) * 1024, 64 * kb, 32 * nb, scr, lane); continue; } r -= I_IN;
        if (r < I_Q) { const int kb = r / 24, nb = r % 24; transpose_item(p.in[I_WQUP] + (size_t)l * 256 * 576, 256, 576, Wq_t + (size_t)(32 * nb) * 256, 64 * kb, 32 * nb, scr, lane); continue; } r -= I_Q;
        if (r < I_KV) { const int kb = r / 24, nb = r % 24; const int n0 = 32 * nb, hh = n0 / 128, wi = n0 % 128;
            bf16* dst = (wi < 64) ? Wk_t + (size_t)(hh * 64 + wi) * 128 : Wv_t + (size_t)(hh * 64 + wi - 64) * 128;
            transpose_item(p.in[I_WKVUP] + (size_t)l * 128 * 768, 128, 768, dst, 64 * kb, n0, scr, lane); continue; } r -= I_KV;
        if (r < I_O) { const int kb = r / 32, nb = r % 32; transpose_item(p.in[I_WOUT] + (size_t)l * 1024 * 1024, 1024, 1024, Wo_t + (size_t)(32 * nb) * 1024, 64 * kb, 32 * nb, scr, lane); continue; } r -= I_O;
        if (r < I_UP) { const int kb = r / 128, nb = r % 128; transpose_item(p.in[I_WUP] + (size_t)l * 1024 * 4096, 1024, 4096, Wup_t + (size_t)(32 * nb) * 1024, 64 * kb, 32 * nb, scr, lane); continue; } r -= I_UP;
        if (r < I_DN) { const int kb = r / 32, nb = r % 32; transpose_item(p.in[I_WDN] + (size_t)l * 4096 * 1024, 4096, 1024, Wdn_t + (size_t)(32 * nb) * 4096, 64 * kb, 32 * nb, scr, lane); continue; } r -= I_DN;
        {
            bf16* base = (r < 32) ? Wk_t + 384 * 128 : Wv_t + 384 * 128; const int q = r & 31;
            unsigned z0; asm volatile("v_mov_b32 %0, 0" : "=v"(z0)); *(u32x4*)((unsigned char*)base + q * 1024 + lane * 16) = (u32x4){z0, z0, z0, z0}; }
    }
}
DI void phase_P(const Params& p, int l, LAS unsigned char* lds) {
    int tid_o = threadIdx.x; asm volatile("" : "+v"(tid_o)); const int tid = tid_o, lane = tid & 63, wave = tid >> 6;
    const int gw = blockIdx.x * 8 + wave, NGW = gridDim.x * 8;
    unsigned char* ws = p.ws;
    bf16* XN = (bf16*)(ws + WS_XN); float* X = p.out;
    if (l == 0) {
        f32x4 gg[4];
#pragma unroll
        for (int j = 0; j < 4; ++j) gg[j] = *(const f32x4*)(p.in[I_NORM1] + 256 * j + 4 * lane);
        for (int m0 = NGW - 1 - gw; m0 < MT; m0 += 2 * NGW) {
            f32x4 v[2][4]; float s2[2] = {0.f, 0.f}; bool ok[2];
#pragma unroll
            for (int q = 0; q < 2; ++q) { const int m = m0 + q * NGW; ok[q] = m < MT; const int mm = ok[q] ? m : m0;
                const float* src = mm < MP ? p.in[I_XP] + (size_t)mm * DM : p.in[I_XS] + (size_t)(mm - MP) * DM;
#pragma unroll
                for (int j = 0; j < 4; ++j) { v[q][j] = __builtin_nontemporal_load((const f32x4*)(src + 256 * j + 4 * lane)); s2[q] += (v[q][j].x * v[q][j].x + v[q][j].y * v[q][j].y) + (v[q][j].z * v[q][j].z + v[q][j].w * v[q][j].w); } }
#pragma unroll
            for (int o = 1; o < 64; o <<= 1) { const float y0 = shx(s2[0], o, lane), y1 = shx(s2[1], o, lane); s2[0] += y0; s2[1] += y1; }
#pragma unroll
            for (int q = 0; q < 2; ++q) { const int m = m0 + q * NGW; if (!ok[q]) continue;
                const float rstd = 1.0f / sqrtf(s2[q] * (1.f / 1024.f) + EPS);
#pragma unroll
                for (int j = 0; j < 4; ++j) {
                    if (m >= MP) *(f32x4*)(X + (size_t)m * DM + 256 * j + 4 * lane) = v[q][j];
                    u32x2 o; o.x = pk2(v[q][j].x * rstd * gg[j].x, v[q][j].y * rstd * gg[j].y); o.y = pk2(v[q][j].z * rstd * gg[j].z, v[q][j].w * rstd * gg[j].w);
                    *(u32x2*)(XN + (size_t)m * DM + 256 * j + 4 * lane) = o; } }
        }
    }
    {
        const float* c1 = p.in[I_CCKV] + (size_t)l * DBAT * PAST * 128; bf16* d1 = (bf16*)(ws + WS_CKV) + (size_t)MT * 128;
        constexpr int N1 = DBAT * PAST * 128 / 512, N2 = DBAT * PAST * 32 / 512;
        const float* c2 = p.in[I_CKR] + (size_t)l * DBAT * PAST * 32; bf16* d2 = (bf16*)(ws + WS_KR) + (size_t)MT * 32;
        for (int it0 = gw; it0 < N1 + N2; it0 += 4 * NGW) {
            f32x4 a[4], bq[4];
#pragma unroll
            for (int q = 0; q < 4; ++q) { const int it = it0 + q * NGW; if (it < N1 + N2) { const float* src = it < N1 ? c1 + (size_t)it * 512 : c2 + (size_t)(it - N1) * 512; a[q] = __builtin_nontemporal_load((const f32x4*)(src + lane * 8)); bq[q] = __builtin_nontemporal_load((const f32x4*)(src + lane * 8 + 4)); } }
#pragma unroll
            for (int q = 0; q < 4; ++q) { const int it = it0 + q * NGW; if (it < N1 + N2) { bf16* dst = it < N1 ? d1 + (size_t)it * 512 : d2 + (size_t)(it - N1) * 512;
                *(u32x4*)(dst + lane * 8) = (u32x4){pk2(a[q].x, a[q].y), pk2(a[q].z, a[q].w), pk2(bq[q].x, bq[q].y), pk2(bq[q].z, bq[q].w)}; } }
        }
    }
}
DI void phase_rms(const Params& p, const float* g, bool to_out, int ns, LAS unsigned char* lds) {
    int tid_o = threadIdx.x; asm volatile("" : "+v"(tid_o)); const int tid = tid_o, lane = tid & 63, wave = tid >> 6;
    const int gw = blockIdx.x * 8 + wave, NGW = gridDim.x * 8;
    bf16* XN = (bf16*)(p.ws + WS_XN); float* X = p.out; const float* part = (const float*)(p.ws + WS_PART);
    {
        LAS float* red = (LAS float*)(lds + LDS_MISC + 64);
        const int quarter = wave & 3, col = 256 * quarter + 4 * lane; const f32x4 gq = *(const f32x4*)(g + col);
        for (int base = 0; base < MS; base += 2 * (int)gridDim.x) {
            const int sr = base + 2 * (int)blockIdx.x + (wave >> 2); const bool ok = sr < MS;
            f32x4 v = {0.f, 0.f, 0.f, 0.f};
            if (ok) {
                float* xr = X + (size_t)(MP + sr) * DM + col; v = *(const f32x4*)xr;
                const float* pr = part + (size_t)sr * DM + col;
                for (int z = 0; z < ns; z += 4) {
                    f32x4 t[4];
#pragma unroll
                    for (int zz = 0; zz < 4; ++zz) t[zz] = __builtin_nontemporal_load((const f32x4*)(pr + (size_t)(z + zz) * MS * DM));
#pragma unroll
                    for (int zz = 0; zz < 4; ++zz) v = v + t[zz];
                }
            }
            const float ssq = wave_sum((v.x * v.x + v.y * v.y) + (v.z * v.z + v.w * v.w), lane);
            if (lane == 0) red[wave] = ssq;
            __syncthreads();
            const int w4 = wave & 4; const float tot = (red[w4] + red[w4 + 1]) + (red[w4 + 2] + red[w4 + 3]);
            const float rstd = 1.0f / sqrtf(tot * (1.f / 1024.f) + EPS);
            if (ok) {
                float* xr = X + (size_t)(MP + sr) * DM + col;
                if (to_out) *(f32x4*)xr = v * rstd * gq;
                else { if (ns > 0) *(f32x4*)xr = v;
                    u32x2 o; o.x = pk2(v.x * rstd * gq.x, v.y * rstd * gq.y); o.y = pk2(v.z * rstd * gq.z, v.w * rstd * gq.w);
                    *(u32x2*)(XN + (size_t)(MP + sr) * DM + col) = o; }
            }
            __syncthreads();
        }
    }
    f32x4 gg[4];
#pragma unroll
    for (int j = 0; j < 4; ++j) gg[j] = *(const f32x4*)(g + 256 * j + 4 * lane);
    for (int m0 = gw; m0 < MP; m0 += 2 * NGW) {
        f32x4 v[2][4]; float s[2] = {0.f, 0.f}; bool ok[2];
#pragma unroll
        for (int q = 0; q < 2; ++q) { const int m = m0 + q * NGW; ok[q] = m < MP; const float* xr = X + (size_t)(ok[q] ? m : m0) * DM;
#pragma unroll
            for (int j = 0; j < 4; ++j) v[q][j] = __builtin_nontemporal_load((const f32x4*)(xr + 256 * j + 4 * lane)); }
#pragma unroll
        for (int q = 0; q < 2; ++q) {
#pragma unroll
            for (int j = 0; j < 4; ++j) s[q] += (v[q][j].x * v[q][j].x + v[q][j].y * v[q][j].y) + (v[q][j].z * v[q][j].z + v[q][j].w * v[q][j].w);
        }
#pragma unroll
        for (int o = 1; o < 64; o <<= 1) { const float y0 = shx(s[0], o, lane), y1 = shx(s[1], o, lane); s[0] += y0; s[1] += y1; }
#pragma unroll
        for (int q = 0; q < 2; ++q) { const int m = m0 + q * NGW; if (!ok[q]) continue;
            const float rstd = 1.0f / sqrtf(s[q] * (1.f / 1024.f) + EPS); float* xr = X + (size_t)m * DM;
#pragma unroll
            for (int j = 0; j < 4; ++j) {
                if (to_out) __builtin_nontemporal_store(v[q][j] * rstd * gg[j], (f32x4*)(xr + 256 * j + 4 * lane));
                else { u32x2 o; o.x = pk2(v[q][j].x * rstd * gg[j].x, v[q][j].y * rstd * gg[j].y); o.y = pk2(v[q][j].z * rstd * gg[j].z, v[q][j].w * rstd * gg[j].w);
                    *(u32x2*)(XN + (size_t)m * DM + 256 * j + 4 * lane) = o; } }
        }
    }
}

template <int NT>
DI void token_part(const Params& p, int l, int row0, int rstride, int lane) {
    const bf16* Zb = (const bf16*)(p.ws + WS_Z);
    u32x2 qw[NT]; unsigned cw[NT]; float k1[NT], k2[NT]; int row[NT]; bool ok[NT];
#pragma unroll
    for (int q = 0; q < NT; ++q) {
        const int rr = row0 + q * rstride; ok[q] = rr < MT; row[q] = ok[q] ? rr : row0;
        const bf16* zr = Zb + (size_t)row[q] * DIN;
        qw[q] = *(const u32x2*)(zr + C_QLAT + 4 * lane); cw[q] = *(const unsigned*)(zr + C_CKV + 2 * lane);
        k1[q] = bf2f(zr[C_KR + (lane & 15)]); k2[q] = bf2f(zr[C_KR + 16 + (lane & 15)]);
    }
    float a[NT][4], cc[NT][2], ss[2 * NT];
#pragma unroll
    for (int q = 0; q < NT; ++q) {
        a[q][0] = __uint_as_float(qw[q].x << 16); a[q][1] = __uint_as_float(qw[q].x & 0xffff0000u); a[q][2] = __uint_as_float(qw[q].y << 16); a[q][3] = __uint_as_float(qw[q].y & 0xffff0000u);
        cc[q][0] = __uint_as_float(cw[q] << 16); cc[q][1] = __uint_as_float(cw[q] & 0xffff0000u);
        ss[2 * q] = (a[q][0] * a[q][0] + a[q][1] * a[q][1]) + (a[q][2] * a[q][2] + a[q][3] * a[q][3]); ss[2 * q + 1] = cc[q][0] * cc[q][0] + cc[q][1] * cc[q][1];
    }
#pragma unroll
    for (int o = 1; o < 64; o <<= 1) {
        float y[2 * NT];
#pragma unroll
        for (int j = 0; j < 2 * NT; ++j) y[j] = shx(ss[j], o, lane);
#pragma unroll
        for (int j = 0; j < 2 * NT; ++j) ss[j] += y[j];
    }
    const f32x4 gq = *(const f32x4*)(p.in[I_QNORM] + l * 256 + 4 * lane); const f32x2 gk = *(const f32x2*)(p.in[I_KVNORM] + l * 128 + 2 * lane);
    const float inv = rope_inv(lane & 15);
#pragma unroll
    for (int q = 0; q < NT; ++q) {
        if (!ok[q]) continue;
        const int rw = row[q]; const bool prompt = rw < MP;
        const int b = prompt ? rw / SEQ : (rw - MP) / DSEQ, t = prompt ? rw % SEQ : (rw - MP) % DSEQ; const int pos = prompt ? t : PAST + t;
        {
            const float rstd = 1.0f / sqrtf(ss[2 * q] * (1.f / 256.f) + EPS);
            u32x2 o; o.x = pk2(a[q][0] * rstd * gq.x, a[q][1] * rstd * gq.y); o.y = pk2(a[q][2] * rstd * gq.z, a[q][3] * rstd * gq.w);
            *(u32x2*)((bf16*)(p.ws + WS_QN) + (size_t)rw * 256 + 4 * lane) = o; }
        {
            const float rstd = 1.0f / sqrtf(ss[2 * q + 1] * (1.f / 128.f) + EPS);
            const float c0 = cc[q][0] * rstd * gk.x, c1 = cc[q][1] * rstd * gk.y;
            float* dst = prompt ? p.out + O_PCKV + ((size_t)(l * NBAT + b) * SEQ + t) * 128 : p.out + O_SCKV + ((size_t)(l * DBAT + b) * DSEQ + t) * 128;
            __builtin_nontemporal_store((f32x2){c0, c1}, (f32x2*)(dst + 2 * lane));
            *(unsigned*)((bf16*)(p.ws + WS_CKV) + (size_t)rw * 128 + 2 * lane) = pk2(c0, c1); }
        if (lane < 16) {
            float sn, cs; sincos_pos((float)pos * inv, sn, cs);
            const float o1 = k1[q] * cs - k2[q] * sn, o2 = k2[q] * cs + k1[q] * sn;
            float* dst = prompt ? p.out + O_PKR + ((size_t)(l * NBAT + b) * SEQ + t) * 32 : p.out + O_SKR + ((size_t)(l * DBAT + b) * DSEQ + t) * 32;
            __builtin_nontemporal_store(o1, dst + lane); __builtin_nontemporal_store(o2, dst + 16 + lane);
            bf16* kd = (bf16*)(p.ws + WS_KR) + (size_t)rw * 32; kd[lane] = f2bf(o1); kd[16 + lane] = f2bf(o2); }
    }
}

DI void cakv_row_out(const Params& p, int l, int j, int lane) {
    const bool prompt = j < 1024; const int b = prompt ? j >> 9 : (j - 1024) / DSEQ, t = prompt ? j & 511 : (j - 1024) % DSEQ;
    const int rw = prompt ? b * SEQ + (SEQ - 512) + t : MP + (j - 1024);
    const bf16* zr = (const bf16*)(p.ws + WS_Z) + (size_t)rw * DIN;
    float* dk = prompt ? p.out + O_PCAK + ((size_t)(l * NBAT + b) * 512 + t) * 384 : p.out + O_SCAK + ((size_t)(l * DBAT + b) * DSEQ + t) * 384;
    float* dv = prompt ? p.out + O_PCAV + ((size_t)(l * NBAT + b) * 512 + t) * 384 : p.out + O_SCAV + ((size_t)(l * DBAT + b) * DSEQ + t) * 384;
    bf16 kk[6], vv[6];
#pragma unroll
    for (int q = 0; q < 6; ++q) { kk[q] = zr[C_CK + 64 * q + lane]; vv[q] = zr[C_CV + 64 * q + lane]; }
#pragma unroll
    for (int q = 0; q < 6; ++q) { __builtin_nontemporal_store(bf2f(kk[q]), dk + 64 * q + lane); __builtin_nontemporal_store(bf2f(vv[q]), dv + 64 * q + lane); }
}

constexpr int GLP = 72;
DI void gla_load_glr(const bf16* Z, int R0, int T, int lane, float (&glr)[16]) {
    const bf16* gp = Z + (size_t)(R0 + (lane < T ? lane : 0)) * DIN + C_GLR;
    const u32x4 a = *(const u32x4*)gp, bq = *(const u32x4*)(gp + 8);
    const unsigned ww[8] = {a.x, a.y, a.z, a.w, bq.x, bq.y, bq.z, bq.w};
#pragma unroll
    for (int i = 0; i < 8; ++i) { glr[2 * i] = __uint_as_float(ww[i] << 16); glr[2 * i + 1] = __uint_as_float(ww[i] & 0xffff0000u); }
}
DI void gla_b8(const float (&glr)[16], const float* W2, const float* gbias, int col0, int T, int lane, float (&la)[8]) {
#pragma unroll
    for (int jj = 0; jj < 8; ++jj) la[jj] = gbias[col0 + jj];
#pragma unroll
    for (int i = 0; i < 16; ++i)
#pragma unroll
        for (int jj = 0; jj < 8; ++jj) la[jj] += glr[i] * W2[i * 256 + col0 + jj];
#pragma unroll
    for (int jj = 0; jj < 8; ++jj) { const float x = la[jj]; float v = (fminf(x, 0.f) - __logf(1.f + __expf(-fabsf(x)))) * (1.f / 16.f); if (lane >= T) v = 0.f; la[jj] = v; }
#pragma unroll
    for (int o = 1; o < 64; o <<= 1) {
        float y[8];
#pragma unroll
        for (int jj = 0; jj < 8; ++jj) y[jj] = __int_as_float(__builtin_amdgcn_ds_bpermute(((lane - o) & 63) << 2, __float_as_int(la[jj])));
        if (lane >= o) {
#pragma unroll
            for (int jj = 0; jj < 8; ++jj) la[jj] += y[jj]; }
    }
}
DI void unpack8(const u32x4 v, float (&f)[8]) {
    const unsigned w[4] = {v.x, v.y, v.z, v.w};
#pragma unroll
    for (int i = 0; i < 4; ++i) { f[2 * i] = __uint_as_float(w[i] << 16); f[2 * i + 1] = __uint_as_float(w[i] & 0xffff0000u); }
}
constexpr int GU_KD = 0, GU_V = 36864, GU_BL = 73728;
DI void gla_u_unit(const Params& p, LAS unsigned char* lds, int l, int b, int c) {
    int tid_o = threadIdx.x; asm volatile("" : "+v"(tid_o)); const int tid = tid_o, lane = tid & 63, w = __builtin_amdgcn_readfirstlane(tid >> 6), r = lane & 31, h2 = lane >> 5;
    const int R0 = b * SEQ + 64 * c;
    const bf16* Z = (const bf16*)(p.ws + WS_Z);
    LAS bf16* KdT = (LAS bf16*)(lds + GU_KD); LAS bf16* VTs = (LAS bf16*)(lds + GU_V); LAS float* Bl = (LAS float*)(lds + GU_BL);
    const float* W2 = p.in[I_WG2] + (size_t)l * 16 * 256; const float* gbias = p.in[I_GBIAS] + l * 256;
    { const int st = tid >> 3, sc8 = tid & 7; const bf16* zr = Z + (size_t)(R0 + st) * DIN + C_GV + 8 * sc8;
        u32x4 v4[4];
#pragma unroll
        for (int hh = 0; hh < 4; ++hh) v4[hh] = *(const u32x4*)(zr + hh * 64);
#pragma unroll
        for (int hh = 0; hh < 4; ++hh) { const unsigned vv[4] = {v4[hh].x, v4[hh].y, v4[hh].z, v4[hh].w};
#pragma unroll
            for (int j = 0; j < 4; ++j) { VTs[(hh * 64 + 8 * sc8 + 2 * j) * GLP + st] = (bf16)(vv[j] & 0xffffu); VTs[(hh * 64 + 8 * sc8 + 2 * j + 1) * GLP + st] = (bf16)(vv[j] >> 16); } } }
    {
        float glr[16]; gla_load_glr(Z, R0, 64, lane, glr);
        const int hh = w >> 1, dk0 = 32 * (w & 1);
        const bf16* kr = Z + (size_t)(R0 + lane) * DIN + C_GK + hh * 64 + dk0;
        u32x4 k4[4];
#pragma unroll
        for (int g = 0; g < 4; ++g) k4[g] = *(const u32x4*)(kr + 8 * g);
#pragma unroll
        for (int g = 0; g < 4; ++g) {
            float la[8]; gla_b8(glr, W2, gbias, hh * 64 + dk0 + 8 * g, 64, lane, la);
            float kf[8]; unpack8(k4[g], kf);
#pragma unroll
            for (int jj = 0; jj < 8; ++jj) { const float bl = __int_as_float(__builtin_amdgcn_readlane(__float_as_int(la[jj]), 63)); const int dk = dk0 + 8 * g + jj;
                KdT[(hh * 64 + dk) * GLP + lane] = f2bf(kf[jj] * __expf(bl - la[jj])); if (lane == 63) Bl[hh * 64 + dk] = bl; }
        }
    }
    __syncthreads();
#pragma unroll
    for (int q2 = 0; q2 < 2; ++q2) {
        const int id = 2 * w + q2, hh = id >> 2, bdk = id & 1, bdv = (id >> 1) & 1;
        f32x16 acc = {};
#pragma unroll
        for (int s = 0; s < 4; ++s) { const bf16x8 a = *(const LAS bf16x8*)(KdT + (hh * 64 + 32 * bdk + r) * GLP + 16 * s + 8 * h2), bb = *(const LAS bf16x8*)(VTs + (hh * 64 + 32 * bdv + r) * GLP + 16 * s + 8 * h2);
            acc = MFMA32(a, bb, acc); }
        float* U = (float*)(p.ws + WS_GU) + ((size_t)((b * 4 + hh) * 128 + c)) * 4096;
#pragma unroll
        for (int i = 0; i < 16; ++i) U[(32 * bdk + crow(i, h2)) * 64 + 32 * bdv + r] = acc[i];
        if (bdv == 0 && h2 == 0) { float* A = (float*)(p.ws + WS_GA) + ((size_t)((b * 4 + hh) * 128 + c)) * 64; A[32 * bdk + r] = __expf(Bl[hh * 64 + 32 * bdk + r]); }
    }
    __syncthreads();
}
constexpr int GO_SLOT = 62720, GO_Q = 0, GO_K = 9216, GO_KD = 18432, GO_V = 27648, GO_A = 36864, GO_O = 46080, GO_BL = 2 * GO_SLOT;
template <bool SAMPLE>
DI void gla_o_unit(const Params& p, LAS unsigned char* lds, int l, int b, int c) {
    int tid_o = threadIdx.x; asm volatile("" : "+v"(tid_o)); const int tid = tid_o, lane = tid & 63, w = __builtin_amdgcn_readfirstlane(tid >> 6), r = lane & 31, h2 = lane >> 5;
    const int R0 = SAMPLE ? MP + b * DSEQ : b * SEQ + 64 * c; const int T = SAMPLE ? DSEQ : 64;
    const bf16* Z = (const bf16*)(p.ws + WS_Z);
    const int hs = w >> 2, wq = w & 3;
    LAS unsigned char* slot = lds + hs * GO_SLOT;
    LAS bf16* Qs = (LAS bf16*)(slot + GO_Q); LAS bf16* Ks = (LAS bf16*)(slot + GO_K); LAS bf16* KdT = (LAS bf16*)(slot + GO_KD); LAS bf16* VTs = (LAS bf16*)(slot + GO_V);
    LAS bf16* Am = (LAS bf16*)(slot + GO_A); LAS float* Om = (LAS float*)(slot + GO_O); LAS float* Bl = (LAS float*)(lds + GO_BL) + hs * 64;
    const float* W2 = p.in[I_WG2] + (size_t)l * 16 * 256; const float* gbias = p.in[I_GBIAS] + l * 256;
    const int st = tid >> 3, sc8 = tid & 7;
    float glr[16]; gla_load_glr(Z, R0, T, lane, glr);
#pragma unroll 1
    for (int hp = 0; hp < 2; ++hp) {
        const int hh = 2 * hp + hs;
        const float* S0 = SAMPLE ? p.in[I_SGLA] + ((size_t)((l * DBAT + b) * 4 + hh)) * 4096 : (const float*)(p.ws + WS_GU) + ((size_t)((b * 4 + hh) * 128 + c)) * 4096;
        u32x4 sb[4];
        { const int bv = wq >> 1;
#pragma unroll
          for (int s2 = 0; s2 < 4; ++s2) { const float* sp = S0 + (size_t)(16 * s2 + 8 * h2) * 64 + 32 * bv + r;
              sb[s2].x = pk2(sp[0], sp[64]); sb[s2].y = pk2(sp[128], sp[192]); sb[s2].z = pk2(sp[256], sp[320]); sb[s2].w = pk2(sp[384], sp[448]); } }
        u32x4 g4[2] = {{0u, 0u, 0u, 0u}, {0u, 0u, 0u, 0u}}; f32x4 gn[2][2];
#pragma unroll
        for (int e = 0; e < 2; ++e) { const int he = 2 * hp + e;
            if (st < T) g4[e] = *(const u32x4*)(Z + (size_t)(R0 + st) * DIN + C_GOUT + he * 64 + 8 * sc8);
            const float* gp = p.in[I_GONORM] + l * 256 + he * 64 + 8 * sc8; gn[e][0] = *(const f32x4*)gp; gn[e][1] = *(const f32x4*)(gp + 4); }
        {
            u32x4 v4[2] = {{0u, 0u, 0u, 0u}, {0u, 0u, 0u, 0u}};
            if (st < T) { const bf16* zr = Z + (size_t)(R0 + st) * DIN + C_GV + (2 * hp) * 64 + 8 * sc8; v4[0] = *(const u32x4*)zr; v4[1] = *(const u32x4*)(zr + 64); }
#pragma unroll
            for (int e = 0; e < 2; ++e) { LAS bf16* VT2 = (LAS bf16*)(lds + e * GO_SLOT + GO_V); const unsigned vv[4] = {v4[e].x, v4[e].y, v4[e].z, v4[e].w};
#pragma unroll
                for (int j = 0; j < 4; ++j) { VT2[(8 * sc8 + 2 * j) * GLP + st] = (bf16)(vv[j] & 0xffffu); VT2[(8 * sc8 + 2 * j + 1) * GLP + st] = (bf16)(vv[j] >> 16); } }
            const int dk0 = 16 * wq;
            u32x4 q4[2] = {{0u, 0u, 0u, 0u}, {0u, 0u, 0u, 0u}}, k4[2] = {{0u, 0u, 0u, 0u}, {0u, 0u, 0u, 0u}};
            if (lane < T) { const bf16* zr = Z + (size_t)(R0 + lane) * DIN + hh * 64 + dk0;
                q4[0] = *(const u32x4*)(zr + C_GQ); q4[1] = *(const u32x4*)(zr + C_GQ + 8); k4[0] = *(const u32x4*)(zr + C_GK); k4[1] = *(const u32x4*)(zr + C_GK + 8); }
#pragma unroll
            for (int g = 0; g < 2; ++g) {
                float la[8]; gla_b8(glr, W2, gbias, hh * 64 + dk0 + 8 * g, T, lane, la);
                float qf[8], kf[8]; unpack8(q4[g], qf); unpack8(k4[g], kf);
                float qt[8], kt[8];
#pragma unroll
                for (int jj = 0; jj < 8; ++jj) { const float bl = __int_as_float(__builtin_amdgcn_readlane(__float_as_int(la[jj]), 63)); const int dk = dk0 + 8 * g + jj;
                    qt[jj] = qf[jj] * 0.125f * __expf(la[jj]); kt[jj] = kf[jj] * __expf(-la[jj]);
                    if (SAMPLE) KdT[dk * GLP + lane] = f2bf(kf[jj] * __expf(bl - la[jj]));
                    if (lane == 63) Bl[dk] = bl; }
                *(LAS u32x4*)(Qs + lane * GLP + dk0 + 8 * g) = (u32x4){pk2(qt[0], qt[1]), pk2(qt[2], qt[3]), pk2(qt[4], qt[5]), pk2(qt[6], qt[7])};
                *(LAS u32x4*)(Ks + lane * GLP + dk0 + 8 * g) = (u32x4){pk2(kt[0], kt[1]), pk2(kt[2], kt[3]), pk2(kt[4], kt[5]), pk2(kt[6], kt[7])};
            }
        }
        __syncthreads();
        {
            const int bi = (wq == 0) ? 0 : 1, bj = (wq == 2) ? 1 : 0;
            if (wq < 3) {
                f32x16 acc = {};
#pragma unroll
                for (int s = 0; s < 4; ++s) { const bf16x8 a = *(const LAS bf16x8*)(Qs + (32 * bi + r) * GLP + 16 * s + 8 * h2), bb = *(const LAS bf16x8*)(Ks + (32 * bj + r) * GLP + 16 * s + 8 * h2);
                    acc = MFMA32(a, bb, acc); }
#pragma unroll
                for (int i = 0; i < 16; ++i) { const int ii = 32 * bi + crow(i, h2), jj = 32 * bj + r; Am[ii * GLP + jj] = f2bf(jj <= ii ? acc[i] : 0.f); }
            } else {
#pragma unroll
                for (int i = 0; i < 16; ++i) Am[crow(i, h2) * GLP + 32 + r] = 0;
            }
            if (SAMPLE) {
                const int bdk = wq & 1, bdv = wq >> 1;
                f32x16 acc = {};
#pragma unroll
                for (int s = 0; s < 4; ++s) { const bf16x8 a = *(const LAS bf16x8*)(KdT + (32 * bdk + r) * GLP + 16 * s + 8 * h2), bb = *(const LAS bf16x8*)(VTs + (32 * bdv + r) * GLP + 16 * s + 8 * h2);
                    acc = MFMA32(a, bb, acc); }
                float* S1 = p.out + O_SGLA + ((size_t)((l * DBAT + b) * 4 + hh)) * 4096;
#pragma unroll
                for (int i = 0; i < 16; ++i) { const int dk = 32 * bdk + crow(i, h2), dv = 32 * bdv + r; S1[dk * 64 + dv] = __expf(Bl[dk]) * S0[dk * 64 + dv] + acc[i]; }
            }
        }
        __syncthreads();
        {
            const int bi = wq & 1, bv = wq >> 1;
            f32x16 acc = {};
#pragma unroll
            for (int s = 0; s < 4; ++s) { const bf16x8 a = *(const LAS bf16x8*)(Am + (32 * bi + r) * GLP + 16 * s + 8 * h2), bb = *(const LAS bf16x8*)(VTs + (32 * bv + r) * GLP + 16 * s + 8 * h2);
                acc = MFMA32(a, bb, acc); }
#pragma unroll
            for (int s = 0; s < 4; ++s) { const bf16x8 a = *(const LAS bf16x8*)(Qs + (32 * bi + r) * GLP + 16 * s + 8 * h2);
                acc = MFMA32(a, __builtin_bit_cast(bf16x8, sb[s]), acc); }
#pragma unroll
            for (int i = 0; i < 16; ++i) Om[(32 * bi + crow(i, h2)) * 65 + 32 * bv + r] = acc[i];
        }
        __syncthreads();
#pragma unroll
        for (int e = 0; e < 2; ++e) {
            const LAS float* Om2 = (const LAS float*)(lds + e * GO_SLOT + GO_O); const int he = 2 * hp + e;
            float o8[8]; float ss = 0.f;
#pragma unroll
            for (int j = 0; j < 8; ++j) { o8[j] = Om2[st * 65 + 8 * sc8 + j]; ss += o8[j] * o8[j]; }
            ss += shx(ss, 1, lane); ss += shx(ss, 2, lane); ss += shx(ss, 4, lane);
            const float rstd = 1.0f / sqrtf(ss * (1.f / 64.f) + EPS);
            if (st < T) {
                float go[8]; unpack8(g4[e], go);
                const float gnn[8] = {gn[e][0].x, gn[e][0].y, gn[e][0].z, gn[e][0].w, gn[e][1].x, gn[e][1].y, gn[e][1].z, gn[e][1].w};
                float vals[8];
#pragma unroll
                for (int j = 0; j < 8; ++j) { const float si = go[j] / (1.f + __expf(-go[j])); vals[j] = o8[j] * rstd * gnn[j] * si; }
                *(u32x4*)((bf16*)(p.ws + WS_XN) + (size_t)(R0 + st) * DM + 384 + he * 64 + 8 * sc8) = (u32x4){pk2(vals[0], vals[1]), pk2(vals[2], vals[3]), pk2(vals[4], vals[5]), pk2(vals[6], vals[7])};
            }
        }
    }
    __syncthreads();
}

DI void gla_scan(const Params& p, int l) {
    const int tid = threadIdx.x;
    if (tid >= 128) return;
    for (int wg = blockIdx.x; wg < 256; wg += gridDim.x) {
        const int bh = wg >> 5, e = (wg & 31) * 128 + tid, dk = e >> 6;
        float* U = (float*)(p.ws + WS_GU) + (size_t)bh * 128 * 4096 + e; const float* A = (const float*)(p.ws + WS_GA) + (size_t)bh * 128 * 64 + dk;
        float s = 0.f;
#pragma unroll 1
        for (int c0 = 0; c0 < 128; c0 += 16) {
            float u[16], a[16];
#pragma unroll
            for (int i = 0; i < 16; ++i) { u[i] = U[(size_t)(c0 + i) * 4096]; a[i] = A[(c0 + i) * 64]; }
#pragma unroll
            for (int i = 0; i < 16; ++i) { U[(size_t)(c0 + i) * 4096] = s; s = a[i] * s + u[i]; }
        }
        p.out[O_PGLA + ((size_t)(l * NBAT * 4 + bh)) * 4096 + e] = s;
    }
}

constexpr int AT_K0 = 0, AT_KB = 13312, AT_V0 = 26624, AT_VB = 8704, AT_VP = 68, AT_TAB = 44032;
template <int MODE>
DI void attn_unit(const Params& p, LAS unsigned char* lds, int l, int b, int h, int qb) {
    constexpr bool MLA = (MODE == 0 || MODE == 2), SAMPLE = (MODE >= 2);
    constexpr int NKS = MLA ? 6 : 4, KP = MLA ? 104 : 72;
    int tid_o = threadIdx.x; asm volatile("" : "+v"(tid_o)); const int tid = tid_o, lane = tid & 63, w = __builtin_amdgcn_readfirstlane(tid >> 6), r = lane & 31, h2 = lane >> 5;
    const bf16* Z = (const bf16*)(p.ws + WS_Z); const bf16* KN = (const bf16*)(p.ws + WS_KN); const bf16* KR = (const bf16*)(p.ws + WS_KR);
    const bf16* VT = (const bf16*)(p.ws + WS_VT); const bf16* QM = (const bf16*)(p.ws + WS_QM);
    int t_first, t_last, wt_lo, wt_hi, qrow, qpos, qmin;
    if (!SAMPLE) {
        const int cw = 4 * qb + (w >> 1);
        t_last = 4 * qb + 3; wt_hi = cw;
        if (MLA) { t_first = 0; wt_lo = 0; } else { t_first = 4 * qb - 8 > 0 ? 4 * qb - 8 : 0; wt_lo = cw - 8 > 0 ? cw - 8 : 0; }
        qpos = 256 * qb + 32 * w + r; qrow = b * SEQ + qpos; qmin = 256 * qb + 32 * w;
    } else {
        t_first = 0; t_last = MLA ? 16 : 8; wt_lo = 0; wt_hi = (w == 0) ? t_last : -1;
        const int qi = r & 15; qrow = MP + b * DSEQ + qi; qpos = (MLA ? PAST : 512) + qi; qmin = MLA ? PAST : 512;
    }
    const float sc = (MLA ? 0.10206207261596577f : 0.125f) * LOG2E;
    bf16x8 q[NKS];
    if (MLA) {
        const bf16* src = QM + (size_t)qrow * 576 + h * 96 + 8 * h2;
#pragma unroll
        for (int s = 0; s < NKS; ++s) q[s] = *(const bf16x8*)(src + 16 * s);
#pragma unroll
        for (int j = 0; j < 8; ++j) { float sn, cs; sincos_pos((float)qpos * rope_inv(8 * h2 + j), sn, cs);
            const float x1 = bf2f((bf16)q[4][j]), x2 = bf2f((bf16)q[5][j]);
            q[4][j] = (short)f2bf((x1 * cs - x2 * sn) * sc); q[5][j] = (short)f2bf((x2 * cs + x1 * sn) * sc); }
#pragma unroll
        for (int s = 0; s < 4; ++s)
#pragma unroll
            for (int j = 0; j < 8; ++j) q[s][j] = (short)f2bf(bf2f((bf16)q[s][j]) * sc);
    } else {
        const bf16* src = Z + (size_t)qrow * DIN + C_CQ + h * 64 + 8 * h2;
#pragma unroll
        for (int s = 0; s < NKS; ++s) q[s] = *(const bf16x8*)(src + 16 * s);
#pragma unroll
        for (int s = 0; s < NKS; ++s)
#pragma unroll
            for (int j = 0; j < 8; ++j) q[s][j] = (short)f2bf(bf2f((bf16)q[s][j]) * sc);
    }
    LAS float* tab = (LAS float*)(lds + AT_TAB);
    if (!MLA) { if (tid < 257) tab[tid] = p.in[I_RELB][(size_t)l * 257 * 6 + tid * 6 + h] * LOG2E; }
    float m = (MODE <= 1) ? 0.f : -INFINITY, lsum = 0.f; f32x16 O0 = {}, O1 = {};
    f32x16 negm = {}, negmb = {};
    float b0u = 0.f;
    struct TileRegs { u32x4 k0, k1, v; };
    TileRegs RA, RB; RA.k0 = (u32x4){0u, 0u, 0u, 0u}; RA.k1 = RA.k0; RA.v = RA.k0; RB = RA;
    auto load_tile = [&](int t, TileRegs& R) {
        if (MODE == 0 || MODE == 2) {
            int rb; if (MODE == 0) rb = b * SEQ + 64 * t; else rb = (t < 16) ? MT + b * PAST + 64 * t : MP + b * DSEQ;
            { const int idx = tid, key = idx / 12, c = idx % 12;
              R.k0 = (c < 8) ? *(const u32x4*)(KN + (size_t)(rb + key) * 384 + h * 64 + 8 * c) : *(const u32x4*)(KR + (size_t)(rb + key) * 32 + 8 * (c - 8)); }
            if (tid < 256) { const int idx = tid + 512, key = idx / 12, c = idx % 12;
              R.k1 = (c < 8) ? *(const u32x4*)(KN + (size_t)(rb + key) * 384 + h * 64 + 8 * c) : *(const u32x4*)(KR + (size_t)(rb + key) * 32 + 8 * (c - 8)); }
            { const int d = tid >> 3, c = tid & 7; R.v = *(const u32x4*)(VT + (size_t)(h * 64 + d) * RALL + rb + 8 * c); }
        } else if (MODE == 1) {
            const int rb = b * SEQ + 64 * t; const int key = tid >> 3, c = tid & 7;
            const bf16* zr = Z + (size_t)(rb + key) * DIN + h * 64 + 8 * c;
            R.k0 = *(const u32x4*)(zr + C_CK); R.v = *(const u32x4*)(zr + C_CV);
        } else {
            const int key = tid >> 3, c = tid & 7;
            if (t < 8) {
                const size_t off = (((size_t)(l * DBAT + b) * 512 + 64 * t + key) * 6 + h) * 64 + 8 * c;
                const float* kp = p.in[I_CCAK] + off; const float* vp = p.in[I_CCAV] + off;
                const f32x4 a = *(const f32x4*)kp, a2 = *(const f32x4*)(kp + 4), bq = *(const f32x4*)vp, b2 = *(const f32x4*)(vp + 4);
                R.k0 = (u32x4){pk2(a.x, a.y), pk2(a.z, a.w), pk2(a2.x, a2.y), pk2(a2.z, a2.w)};
                R.v = (u32x4){pk2(bq.x, bq.y), pk2(bq.z, bq.w), pk2(b2.x, b2.y), pk2(b2.z, b2.w)};
            } else {
                const bf16* zr = Z + (size_t)(MP + b * DSEQ + (key & 15)) * DIN + h * 64 + 8 * c;
                R.k0 = *(const u32x4*)(zr + C_CK); R.v = *(const u32x4*)(zr + C_CV);
            }
        }
    };
    auto store_tile = [&](int buf, const TileRegs& R) {
        LAS unsigned char* Kb = lds + AT_K0 + buf * AT_KB; LAS unsigned char* Vb = lds + AT_V0 + buf * AT_VB;
        if (MLA) {
            { const int idx = tid, key = idx / 12, c = idx % 12; *(LAS u32x4*)(Kb + key * (KP * 2) + c * 16) = R.k0; }
            if (tid < 256) { const int idx = tid + 512, key = idx / 12, c = idx % 12; *(LAS u32x4*)(Kb + key * (KP * 2) + c * 16) = R.k1; }
            { const int d = tid >> 3, c = tid & 7; LAS unsigned char* dp = Vb + d * (AT_VP * 2) + c * 16;
              *(LAS u32x2*)dp = (u32x2){R.v.x, R.v.y}; *(LAS u32x2*)(dp + 8) = (u32x2){R.v.z, R.v.w}; }
        } else {
            const int key = tid >> 3, c = tid & 7;
            *(LAS u32x4*)(Kb + key * (KP * 2) + c * 16) = R.k0;
            const unsigned vv[4] = {R.v.x, R.v.y, R.v.z, R.v.w};
#pragma unroll
            for (int j = 0; j < 4; ++j) { *(LAS bf16*)(Vb + (8 * c + 2 * j) * (AT_VP * 2) + key * 2) = (bf16)(vv[j] & 0xffffu); *(LAS bf16*)(Vb + (8 * c + 2 * j + 1) * (AT_VP * 2) + key * 2) = (bf16)(vv[j] >> 16); }
        }
    };
    load_tile(t_first, RA); store_tile(0, RA);
    __syncthreads();
    if (MODE == 1) { b0u = tab[0];
#pragma unroll
        for (int i = 0; i < 16; ++i) negmb[i] = b0u; }
    if (t_first + 1 <= t_last) load_tile(t_first + 1, RA);
    if (t_first + 2 <= t_last) load_tile(t_first + 2, RB);
    auto compute = [&](int t, int cur) {
        if (t >= wt_lo && t <= wt_hi) {
            const LAS unsigned char* Kb = lds + AT_K0 + cur * AT_KB; const LAS unsigned char* Vb = lds + AT_V0 + cur * AT_VB;
            bf16x8 kf[2 * NKS];
#pragma unroll
            for (int s = 0; s < NKS; ++s) { kf[2 * s] = *(const LAS bf16x8*)(Kb + (r * KP + 16 * s + 8 * h2) * 2); kf[2 * s + 1] = *(const LAS bf16x8*)(Kb + ((32 + r) * KP + 16 * s + 8 * h2) * 2); }
            __builtin_amdgcn_sched_barrier(0);
            f32x16 p0, p1;
            const bool cbias = (MODE == 1) && ((64 * t + 63 - qmin) <= -128);
            if (MODE == 0) { p0 = negm; p1 = negm; } else if (MODE == 1) { if (cbias) { p0 = negmb; p1 = negmb; } else { p0 = negm; p1 = negm; } } else { p0 = (f32x16){}; p1 = (f32x16){}; }
            s16x4 vlo0[4], vhi0[4], vlo1[4], vhi1[4];
            const LAS unsigned char* v0b = Vb + (r * AT_VP + 4 * h2) * 2; const LAS unsigned char* v1b = Vb + ((32 + r) * AT_VP + 4 * h2) * 2;
#pragma unroll
            for (int s = 0; s < NKS; ++s) {
                p0 = MFMA32(kf[2 * s], q[s], p0); p1 = MFMA32(kf[2 * s + 1], q[s], p1);
                if (s < 4) { vlo0[s] = *(const LAS s16x4*)(v0b + 32 * s); vhi0[s] = *(const LAS s16x4*)(v0b + 32 * s + 16); vlo1[s] = *(const LAS s16x4*)(v1b + 32 * s); vhi1[s] = *(const LAS s16x4*)(v1b + 32 * s + 16); }
                __builtin_amdgcn_sched_barrier(0);
            }
            float mt = -INFINITY;
            const bool lastpart = SAMPLE && (t == t_last);
            if (MODE == 1 && cbias) {
#pragma unroll
                for (int i = 0; i < 16; ++i) mt = __builtin_amdgcn_fmed3f(__builtin_amdgcn_fmed3f(mt, p0[i], INFINITY), p1[i], INFINITY);
            } else if (!MLA) {
                const float b0 = (MODE == 1) ? 0.f : tab[0];
#pragma unroll
                for (int i = 0; i < 16; ++i) {
                    const int k0 = 64 * t + crow(i, h2), k1 = k0 + 32; float bb0 = b0, bb1 = b0;
                    if (!cbias) { int r0 = k0 - qpos, r1 = k1 - qpos; r0 = r0 < -128 ? -128 : (r0 > 128 ? 128 : r0); r1 = r1 < -128 ? -128 : (r1 > 128 ? 128 : r1);
                        bb0 = tab[r0 + 128]; bb1 = tab[r1 + 128]; }
                    float s0 = p0[i] + bb0, s1 = p1[i] + bb1;
                    if (lastpart) { if (crow(i, h2) >= 16) s0 = -INFINITY; s1 = -INFINITY; }
                    p0[i] = s0; p1[i] = s1; mt = __builtin_amdgcn_fmed3f(__builtin_amdgcn_fmed3f(mt, s0, INFINITY), s1, INFINITY);
                }
            } else {
#pragma unroll
                for (int i = 0; i < 16; ++i) {
                    float s0 = p0[i], s1 = p1[i];
                    if (lastpart) { if (crow(i, h2) >= 16) s0 = -INFINITY; s1 = -INFINITY; }
                    p0[i] = s0; p1[i] = s1; mt = __builtin_amdgcn_fmed3f(__builtin_amdgcn_fmed3f(mt, s0, INFINITY), s1, INFINITY);
                }
            }
            mt = fmaxf(mt, shx(mt, 32, lane));
            float rs = 0.f;
            if (MODE <= 1) {
                const bool first = (t == wt_lo);
                if (first || __builtin_amdgcn_ballot_w64(mt > 8.0f) != 0ull) {
                    const float dl = first ? mt : fmaxf(mt, 0.f);
                    m += dl;
#pragma unroll
                    for (int i = 0; i < 16; ++i) { p0[i] -= dl; p1[i] -= dl; negm[i] = -m; if (MODE == 1) negmb[i] = b0u - m; }
                    if (!first) { const float alpha = __builtin_amdgcn_exp2f(-dl); lsum *= alpha;
#pragma unroll
                        for (int i = 0; i < 16; ++i) { O0[i] *= alpha; O1[i] *= alpha; } }
                }
#pragma unroll
                for (int i = 0; i < 16; ++i) { p0[i] = __builtin_amdgcn_exp2f(p0[i]); p1[i] = __builtin_amdgcn_exp2f(p1[i]); rs += p0[i] + p1[i]; }
            } else {
                const float mn = fmaxf(m, mt);
                if (__builtin_amdgcn_ballot_w64(mn > m) != 0ull) {
                    const float alpha = __builtin_amdgcn_exp2f(m - mn); m = mn; lsum *= alpha;
#pragma unroll
                    for (int i = 0; i < 16; ++i) { O0[i] *= alpha; O1[i] *= alpha; }
                }
#pragma unroll
                for (int i = 0; i < 16; ++i) { p0[i] = __builtin_amdgcn_exp2f(p0[i] - mn); p1[i] = __builtin_amdgcn_exp2f(p1[i] - mn); rs += p0[i] + p1[i]; }
            }
            lsum += rs;
            bf16x8 pb[4];
            { u32x4 x;
              x = (u32x4){pk2(p0[0], p0[1]), pk2(p0[2], p0[3]), pk2(p0[4], p0[5]), pk2(p0[6], p0[7])}; pb[0] = __builtin_bit_cast(bf16x8, x);
              x = (u32x4){pk2(p0[8], p0[9]), pk2(p0[10], p0[11]), pk2(p0[12], p0[13]), pk2(p0[14], p0[15])}; pb[1] = __builtin_bit_cast(bf16x8, x);
              x = (u32x4){pk2(p1[0], p1[1]), pk2(p1[2], p1[3]), pk2(p1[4], p1[5]), pk2(p1[6], p1[7])}; pb[2] = __builtin_bit_cast(bf16x8, x);
              x = (u32x4){pk2(p1[8], p1[9]), pk2(p1[10], p1[11]), pk2(p1[12], p1[13]), pk2(p1[14], p1[15])}; pb[3] = __builtin_bit_cast(bf16x8, x); }
#pragma unroll
            for (int ks = 0; ks < 4; ++ks) {
                const bf16x8 va0 = __builtin_shufflevector(vlo0[ks], vhi0[ks], 0, 1, 2, 3, 4, 5, 6, 7), va1 = __builtin_shufflevector(vlo1[ks], vhi1[ks], 0, 1, 2, 3, 4, 5, 6, 7);
                O0 = MFMA32(va0, pb[ks], O0); O1 = MFMA32(va1, pb[ks], O1);
            }
        }
    };
    int cur = 0;
    for (int t = t_first; t <= t_last; t += 2) {
        compute(t, cur);
        if (t + 1 <= t_last) store_tile(cur ^ 1, RA);
        if (t + 3 <= t_last) load_tile(t + 3, RA);
        asm volatile("s_waitcnt lgkmcnt(0)\n\ts_barrier" ::: "memory");
        cur ^= 1;
        if (t + 1 > t_last) break;
        compute(t + 1, cur);
        if (t + 2 <= t_last) store_tile(cur ^ 1, RB);
        if (t + 4 <= t_last) load_tile(t + 4, RB);
        asm volatile("s_waitcnt lgkmcnt(0)\n\ts_barrier" ::: "memory");
        cur ^= 1;
    }
    const float lt = lsum + shx(lsum, 32, lane);
    const bool valid = SAMPLE ? (w == 0 && r < 16) : true;
    if (valid) {
        const float inv = 1.0f / lt;
        bf16* dst = (bf16*)(p.ws + WS_XN) + (size_t)qrow * DM + (MLA ? 0 : 640) + h * 64 + 4 * h2;
#pragma unroll
        for (int g = 0; g < 4; ++g) {
            *(u32x2*)(dst + 8 * g) = (u32x2){pk2(O0[4 * g] * inv, O0[4 * g + 1] * inv), pk2(O0[4 * g + 2] * inv, O0[4 * g + 3] * inv)};
            *(u32x2*)(dst + 32 + 8 * g) = (u32x2){pk2(O1[4 * g] * inv, O1[4 * g + 1] * inv), pk2(O1[4 * g + 2] * inv, O1[4 * g + 3] * inv)};
        }
    }
}

template <bool MLA>
DI void attn_sample_wave(const Params& p, const LAS float* tabs, int l, int b, int h, int lane) {
    constexpr int NKS = MLA ? 6 : 4, NT = MLA ? 17 : 9;
    const int r = lane & 31, h2 = lane >> 5, qi = r & 15;
    const bf16* Z = (const bf16*)(p.ws + WS_Z); const bf16* KN = (const bf16*)(p.ws + WS_KN); const bf16* KR = (const bf16*)(p.ws + WS_KR);
    const bf16* VT = (const bf16*)(p.ws + WS_VT); const bf16* QM = (const bf16*)(p.ws + WS_QM);
    const int qrow = MP + b * DSEQ + qi, qpos = (MLA ? PAST : 512) + qi;
    const float sc = (MLA ? 0.10206207261596577f : 0.125f) * LOG2E;
    bf16x8 q[NKS];
    if (MLA) {
        const bf16* src = QM + (size_t)qrow * 576 + h * 96 + 8 * h2;
#pragma unroll
        for (int s = 0; s < NKS; ++s) q[s] = *(const bf16x8*)(src + 16 * s);
#pragma unroll
        for (int j = 0; j < 8; ++j) { float sn, cs; sincos_pos((float)qpos * rope_inv(8 * h2 + j), sn, cs);
            const float x1 = bf2f((bf16)q[4][j]), x2 = bf2f((bf16)q[5][j]);
            q[4][j] = (short)f2bf((x1 * cs - x2 * sn) * sc); q[5][j] = (short)f2bf((x2 * cs + x1 * sn) * sc); }
#pragma unroll
        for (int s = 0; s < 4; ++s)
#pragma unroll
            for (int j = 0; j < 8; ++j) q[s][j] = (short)f2bf(bf2f((bf16)q[s][j]) * sc);
    } else {
        const bf16* src = Z + (size_t)qrow * DIN + C_CQ + h * 64 + 8 * h2;
#pragma unroll
        for (int s = 0; s < NKS; ++s) q[s] = *(const bf16x8*)(src + 16 * s);
#pragma unroll
        for (int s = 0; s < NKS; ++s)
#pragma unroll
            for (int j = 0; j < 8; ++j) q[s][j] = (short)f2bf(bf2f((bf16)q[s][j]) * sc);
    }
    const LAS float* tab = tabs + h * 257;
    float m = -INFINITY, lsum = 0.f; f32x16 O0 = {}, O1 = {};
#pragma unroll 1
    for (int t = 0; t < NT; ++t) {
        const bool last = (t == NT - 1);
        bf16x8 kf[2 * NKS];
        if (MLA) {
            const int rb = last ? MP + b * DSEQ : MT + b * PAST + 64 * t;
#pragma unroll
            for (int s = 0; s < 4; ++s) { kf[2 * s] = *(const bf16x8*)(KN + (size_t)(rb + r) * 384 + h * 64 + 16 * s + 8 * h2); kf[2 * s + 1] = *(const bf16x8*)(KN + (size_t)(rb + 32 + r) * 384 + h * 64 + 16 * s + 8 * h2); }
#pragma unroll
            for (int s = 4; s < 6; ++s) { kf[2 * s] = *(const bf16x8*)(KR + (size_t)(rb + r) * 32 + 16 * (s - 4) + 8 * h2); kf[2 * s + 1] = *(const bf16x8*)(KR + (size_t)(rb + 32 + r) * 32 + 16 * (s - 4) + 8 * h2); }
        } else if (!last) {
            const float* kb = p.in[I_CCAK] + (((size_t)(l * DBAT + b) * 512 + 64 * t) * 6 + h) * 64 + 8 * h2;
#pragma unroll
            for (int s = 0; s < 4; ++s)
#pragma unroll
                for (int e = 0; e < 2; ++e) { const float* kp = kb + (size_t)(32 * e + r) * 384 + 16 * s; const f32x4 a = *(const f32x4*)kp, a2 = *(const f32x4*)(kp + 4);
                    const u32x4 x = {pk2(a.x, a.y), pk2(a.z, a.w), pk2(a2.x, a2.y), pk2(a2.z, a2.w)}; kf[2 * s + e] = __builtin_bit_cast(bf16x8, x); }
        } else {
#pragma unroll
            for (int s = 0; s < 4; ++s) { const bf16x8 x = *(const bf16x8*)(Z + (size_t)(MP + b * DSEQ + qi) * DIN + C_CK + h * 64 + 16 * s + 8 * h2); kf[2 * s] = x; kf[2 * s + 1] = x; }
        }
        f32x16 p0 = {}, p1 = {};
#pragma unroll
        for (int s = 0; s < NKS; ++s) { p0 = MFMA32(kf[2 * s], q[s], p0); p1 = MFMA32(kf[2 * s + 1], q[s], p1); }
        bf16x8 va[2][4];
        if (MLA) {
            const int rb = last ? MP + b * DSEQ : MT + b * PAST + 64 * t;
#pragma unroll
            for (int db = 0; db < 2; ++db)
#pragma unroll
                for (int ks = 0; ks < 4; ++ks) { const bf16* vp = VT + (size_t)(h * 64 + 32 * db + r) * RALL + rb + 16 * ks + 4 * h2;
                    const s16x4 lo = *(const s16x4*)vp, hi = *(const s16x4*)(vp + 8); va[db][ks] = __builtin_shufflevector(lo, hi, 0, 1, 2, 3, 4, 5, 6, 7); }
        } else if (!last) {
            const float* vb = p.in[I_CCAV] + (((size_t)(l * DBAT + b) * 512 + 64 * t) * 6 + h) * 64 + r;
#pragma unroll
            for (int db = 0; db < 2; ++db)
#pragma unroll
                for (int ks = 0; ks < 4; ++ks) { const float* vp = vb + (size_t)(16 * ks + 4 * h2) * 384 + 32 * db;
                    const u32x4 x = {pk2(vp[0], vp[384]), pk2(vp[768], vp[1152]), pk2(vp[8 * 384], vp[9 * 384]), pk2(vp[10 * 384], vp[11 * 384])}; va[db][ks] = __builtin_bit_cast(bf16x8, x); }
        } else {
#pragma unroll
            for (int db = 0; db < 2; ++db)
#pragma unroll
                for (int ks = 0; ks < 4; ++ks) { bf16x8 x;
#pragma unroll
                    for (int j = 0; j < 8; ++j) { const int key = (16 * ks + 8 * (j >> 2) + 4 * h2 + (j & 3)) & 15; x[j] = (short)Z[(size_t)(MP + b * DSEQ + key) * DIN + C_CV + h * 64 + 32 * db + r]; }
                    va[db][ks] = x; }
        }
        float mt = -INFINITY;
        if (!MLA) {
            const bool cbias = (64 * t + 63 - 512) <= -128; const float b0 = tab[0];
#pragma unroll
            for (int i = 0; i < 16; ++i) {
                const int k0 = 64 * t + crow(i, h2), k1 = k0 + 32; float bb0 = b0, bb1 = b0;
                if (!cbias) { int r0 = k0 - qpos, r1 = k1 - qpos; r0 = r0 < -128 ? -128 : (r0 > 128 ? 128 : r0); r1 = r1 < -128 ? -128 : (r1 > 128 ? 128 : r1);
                    bb0 = tab[r0 + 128]; bb1 = tab[r1 + 128]; }
                float s0 = p0[i] + bb0, s1 = p1[i] + bb1;
                if (last) { if (crow(i, h2) >= 16) s0 = -INFINITY; s1 = -INFINITY; }
                p0[i] = s0; p1[i] = s1; mt = __builtin_amdgcn_fmed3f(__builtin_amdgcn_fmed3f(mt, s0, INFINITY), s1, INFINITY);
            }
        } else {
#pragma unroll
            for (int i = 0; i < 16; ++i) {
                float s0 = p0[i], s1 = p1[i];
                if (last) { if (crow(i, h2) >= 16) s0 = -INFINITY; s1 = -INFINITY; }
                p0[i] = s0; p1[i] = s1; mt = __builtin_amdgcn_fmed3f(__builtin_amdgcn_fmed3f(mt, s0, INFINITY), s1, INFINITY);
            }
        }
        mt = fmaxf(mt, shx(mt, 32, lane));
        const float mn = fmaxf(m, mt); const float alpha = __builtin_amdgcn_exp2f(m - mn); m = mn; lsum *= alpha;
#pragma unroll
        for (int i = 0; i < 16; ++i) { O0[i] *= alpha; O1[i] *= alpha; }
        float rs = 0.f;
#pragma unroll
        for (int i = 0; i < 16; ++i) { p0[i] = __builtin_amdgcn_exp2f(p0[i] - mn); p1[i] = __builtin_amdgcn_exp2f(p1[i] - mn); rs += p0[i] + p1[i]; }
        lsum += rs;
        bf16x8 pb[4];
        { u32x4 x;
          x = (u32x4){pk2(p0[0], p0[1]), pk2(p0[2], p0[3]), pk2(p0[4], p0[5]), pk2(p0[6], p0[7])}; pb[0] = __builtin_bit_cast(bf16x8, x);
          x = (u32x4){pk2(p0[8], p0[9]), pk2(p0[10], p0[11]), pk2(p0[12], p0[13]), pk2(p0[14], p0[15])}; pb[1] = __builtin_bit_cast(bf16x8, x);
          x = (u32x4){pk2(p1[0], p1[1]), pk2(p1[2], p1[3]), pk2(p1[4], p1[5]), pk2(p1[6], p1[7])}; pb[2] = __builtin_bit_cast(bf16x8, x);
          x = (u32x4){pk2(p1[8], p1[9]), pk2(p1[10], p1[11]), pk2(p1[12], p1[13]), pk2(p1[14], p1[15])}; pb[3] = __builtin_bit_cast(bf16x8, x); }
#pragma unroll
        for (int ks = 0; ks < 4; ++ks) { O0 = MFMA32(va[0][ks], pb[ks], O0); O1 = MFMA32(va[1][ks], pb[ks], O1); }
    }
    const float lt = lsum + shx(lsum, 32, lane);
    if (r < 16) {
        const float inv = 1.0f / lt;
        bf16* dst = (bf16*)(p.ws + WS_XN) + (size_t)qrow * DM + (MLA ? 0 : 640) + h * 64 + 4 * h2;
#pragma unroll
        for (int g = 0; g < 4; ++g) {
            *(u32x2*)(dst + 8 * g) = (u32x2){pk2(O0[4 * g] * inv, O0[4 * g + 1] * inv), pk2(O0[4 * g + 2] * inv, O0[4 * g + 3] * inv)};
            *(u32x2*)(dst + 32 + 8 * g) = (u32x2){pk2(O1[4 * g] * inv, O1[4 * g + 1] * inv), pk2(O1[4 * g + 2] * inv, O1[4 * g + 3] * inv)};
        }
    }
}
template <bool MLA>
DI void attn_sample_item(const Params& p, LAS unsigned char* lds, int l, int item) {
    int tid_o = threadIdx.x; asm volatile("" : "+v"(tid_o)); const int tid = tid_o, lane = tid & 63, w = __builtin_amdgcn_readfirstlane(tid >> 6);
    LAS float* tabs = (LAS float*)lds;
    if (!MLA) { for (int i = tid; i < 6 * 257; i += 512) { const int hh = i / 257, e = i % 257; tabs[i] = p.in[I_RELB][(size_t)l * 257 * 6 + e * 6 + hh] * LOG2E; } __syncthreads(); }
    const int unit = 8 * item + w;
    attn_sample_wave<MLA>(p, tabs, l, unit / 6, unit % 6, lane);
}

#define XB_TMO      128
#define XB_XCNT(j)  (256  + 64 * (j))
#define XB_XSUB(j)  (1280 + 64 * (j))
#define XB_XGEN(j)  (2304 + 64 * (j))
#define XB_TOP      3328
#define XB_TOPGEN   3392
#define XCD_BAR_WORDS 3456
#define XB_SPIN_CAP (1u << 18)

__device__ __forceinline__ unsigned xb_ld(unsigned* p)              { return __hip_atomic_load(p, __ATOMIC_RELAXED, __HIP_MEMORY_SCOPE_AGENT); }
__device__ __forceinline__ unsigned xb_add(unsigned* p, unsigned v) { return __hip_atomic_fetch_add(p, v, __ATOMIC_RELAXED, __HIP_MEMORY_SCOPE_AGENT); }
__device__ __forceinline__ unsigned xb_xcc_id() { return (unsigned)__builtin_amdgcn_s_getreg((3 << 11) | 20) & 0xFu; }
#define XB_SPIN(cond, bar) do { unsigned _sp = 0; while (cond) { __builtin_amdgcn_s_sleep(1); \
    if ((++_sp & 255u) == 0u) { if (xb_ld(&(bar)[XB_TMO])) break; if (_sp > XB_SPIN_CAP) { atomicAdd(&(bar)[XB_TMO], 1u); break; } } } } while (0)

struct XcdBarrier {
    unsigned* bar; unsigned x;
    volatile LAS unsigned* st;
};

__device__ __forceinline__ XcdBarrier xcd_barrier_post(unsigned* bar, volatile LAS unsigned* st) {
    XcdBarrier b; b.bar = bar; b.x = xb_xcc_id(); b.st = st;
    if (threadIdx.x == 0) (void)xb_add(&bar[XB_XCNT(b.x)], 1u);
    return b;
}
__device__ __forceinline__ void xcd_barrier_complete(unsigned* bar, unsigned x, unsigned& nloc, unsigned& nx) {
    const unsigned G = gridDim.x * gridDim.y * gridDim.z;
    unsigned sum, cnt, mine, sp = 0u;
    for (;;) {
        sum = 0u; cnt = 0u; mine = 0u;
#pragma unroll
        for (unsigned j = 0; j < 16; ++j) { const unsigned c = xb_ld(&bar[XB_XCNT(j)]); sum += c; cnt += (c > 0u) ? 1u : 0u; mine = (j == x) ? c : mine; }
        if (sum == G) break;
        __builtin_amdgcn_s_sleep(1);
        if ((++sp & 255u) == 0u) { if (xb_ld(&bar[XB_TMO])) break; if (sp > XB_SPIN_CAP) { atomicAdd(&bar[XB_TMO], 1u); break; } }
    }
    nloc = mine > 0u ? mine : 1u; nx = cnt > 0u ? cnt : 1u;
}

__device__ __forceinline__ void xcd_barrier(const XcdBarrier& b) {
    asm volatile("s_waitcnt vmcnt(0)" ::: "memory");
    __syncthreads();
    if (threadIdx.x == 0) {
        unsigned* bar = b.bar;
        __builtin_amdgcn_s_waitcnt(0);
        unsigned nloc = b.st[0], nx = b.st[1];
        if (nloc == 0u) { xcd_barrier_complete(bar, b.x, nloc, nx); b.st[0] = nloc; b.st[1] = nx; }
        const unsigned old = xb_add(&bar[XB_XSUB(b.x)], 1u);
        const unsigned gen = old / nloc;
        if (old + 1u == (gen + 1u) * nloc) {
            __builtin_amdgcn_fence(__ATOMIC_RELEASE, "agent");
            asm volatile("s_waitcnt vmcnt(0)" ::: "memory");
            const unsigned og = xb_add(&bar[XB_TOP], 1u);
            const unsigned tg = og / nx;
            if (og + 1u == (tg + 1u) * nx) xb_add(&bar[XB_TOPGEN], 1u);
            else XB_SPIN(xb_ld(&bar[XB_TOPGEN]) == tg, bar);
            __builtin_amdgcn_fence(__ATOMIC_ACQUIRE, "agent");
            xb_add(&bar[XB_XGEN(b.x)], 1u);
            asm volatile("s_waitcnt vmcnt(0)" ::: "memory");
        } else {
            XB_SPIN(xb_ld(&bar[XB_XGEN(b.x)]) == gen, bar);
            __builtin_amdgcn_fence(__ATOMIC_ACQUIRE, "agent");
            asm volatile("s_waitcnt vmcnt(0)" ::: "memory");
        }
    }
    __syncthreads();
}

#ifndef PHMASK
#define PHMASK 0x3ff
#endif
#define ON(k) ((PHMASK >> (k)) & 1)
#ifndef UMASK
#define UMASK 0x3f
#endif
#define UON(k) ((UMASK >> (k)) & 1)
#ifndef DUPMASK
#define DUPMASK 0
#endif
#define DUP(k) ((DUPMASK >> (k)) & 1)
__global__ void __launch_bounds__(512) mega_fwd(Params p_arg) {
    extern __shared__ __attribute__((aligned(16))) unsigned char lds_raw[];
    LAS unsigned char* lds = (LAS unsigned char*)lds_raw;
    cg::grid_group grid = cg::this_grid();
    const int ph_lo = p_arg.ph_lo, ph_hi = p_arg.ph_hi;
    volatile LAS unsigned* MISC = (volatile LAS unsigned*)(lds + LDS_MISC);
    if (threadIdx.x < 32) MISC[threadIdx.x] = 0u;
    __syncthreads();
    const XcdBarrier bar = xcd_barrier_post((unsigned*)(p_arg.ws + WS_CTL) + 4096, MISC + 8);
#define GRID_BAR() xcd_barrier(bar)
#pragma unroll 1
    for (int ph = ph_lo; ph < ph_hi; ++ph) {
#if defined(__HIP_DEVICE_COMPILE__)
        typedef __attribute__((address_space(4))) const Params* KP;
        KP kp = (KP)__builtin_amdgcn_kernarg_segment_ptr(); asm volatile("" : "+s"(kp));
        const Params p = *kp;
#else
        const Params p = p_arg;
#endif
        int l = ph / 9, k = ph - 9 * l;
        asm volatile("" : "+s"(l), "+s"(k));
        const int nrep = 1 + ((l < 2) ? ((DUPMASK >> k) & 1) : 0);
#pragma unroll 1
        for (int rep = 0; rep < nrep; ++rep) {
        if (rep > 0) GRID_BAR();
        unsigned char* ws = p.ws; asm volatile("" : "+s"(ws));
        const size_t wofs = (l == 1) ? WS_W1OFS : 0;
        if (l == 2) { if (ON(9)) phase_rms(p, p.in[I_FNORM], true, 16, lds); }
        else if (k == 0) { if (ON(0)) { if (l == 0) phase_weights(p, 0, lds, 0, gridDim.x); phase_P(p, l, lds); if (l == 1) phase_rms(p, p.in[I_NORM1] + DM, false, rep > 0 ? 0 : 16, lds); } }
        else if (k == 1 || k == 3) {
            const int nd = (k == 1) ? 1 : 3;
            if (ON(1) || ON(3)) {
#pragma unroll 1
            for (int d = 0; d < nd; ++d) {
                pg8::Gemm g; pg8::EpiStore<0> E;
                if (k == 1) { g = pg8::Gemm{(const bf16*)(ws + WS_XN), (const bf16*)(ws + wofs + WS_WIN), MT, 2816, 1024}; E = pg8::EpiStore<0>{(bf16*)(ws + WS_Z), DIN, DIN, MT}; }
                else if (d == 0) { g = pg8::Gemm{(const bf16*)(ws + WS_QN), (const bf16*)(ws + wofs + WS_WQ), MT, 768, 256}; E = pg8::EpiStore<0>{(bf16*)(ws + WS_QM), 576, 576, MT}; }
                else if (d == 1) { g = pg8::Gemm{(const bf16*)(ws + WS_CKV), (const bf16*)(ws + wofs + WS_WK), RALL, 512, 128}; E = pg8::EpiStore<0>{(bf16*)(ws + WS_KN), 384, 384, RALL}; }
                else { g = pg8::Gemm{(const bf16*)(ws + wofs + WS_WV), (const bf16*)(ws + WS_CKV), 512, RALL, 128}; E = pg8::EpiStore<0>{(bf16*)(ws + WS_VT), RALL, RALL, 384}; }
                const int G_ = (int)gridDim.x; const int crot = (k == 1) ? (int)blockIdx.x : (d == 0 ? (int)blockIdx.x : (d == 1 ? ((int)blockIdx.x + 58) % G_ : ((int)blockIdx.x + 182) % G_));
                pg8::StaticOrder S; S.init(g.M, g.N, gridDim.x, crot);
                pg8::gemm_phase<pg8::EpiStore<0>, pg8::StaticOrder, true, true>(lds, g, S, E);
            }
            if (k == 3) gla_scan(p, l);
            }
        }
        else if (k == 2) {
            if (ON(2)) {
            int tid_o = threadIdx.x; asm volatile("" : "+v"(tid_o)); const int lane = tid_o & 63, wave = tid_o >> 6;
            {
                const int gw = blockIdx.x * 8 + wave, NGW = gridDim.x * 8;
                for (int r0 = gw; r0 < MT; r0 += 4 * NGW) token_part<4>(p, l, r0, NGW, lane);
                for (int j = NGW - 1 - gw; j < 1536; j += NGW) cakv_row_out(p, l, j, lane);
                for (int u = blockIdx.x; u < 256; u += gridDim.x) gla_u_unit(p, lds, l, u >> 7, u & 127);
            }
            }
        }
        else if (k == 4) {
            if (ON(4)) {
            int tid_o = threadIdx.x; asm volatile("" : "+v"(tid_o)); const int tid = tid_o;
            unsigned* ctr = (unsigned*)(ws + WS_CTL) + 64 * l + 256 * rep;
            LAS unsigned* slot = (LAS unsigned*)(lds + LDS_MISC);
            for (;;) {
                __syncthreads();
                if (tid == 0) *slot = atomicAdd(ctr, 1u);
                __syncthreads();
                int u = (int)*slot;
#ifdef DUPU
                {
                    constexpr int lo_[6] = {80, 464, 720, 0, 24, 48}, hi_[6] = {464, 720, 1104, 24, 48, 80};
                    if (u >= 1104 + (hi_[DUPU] - lo_[DUPU])) break;
                    if (u >= 1104) u = lo_[DUPU] + (u - 1104);
                }
#else
                if (u >= 1104) break;
#endif
                if (UON(3) && u < 24) { attn_sample_item<true>(p, lds, l, u); }
                else if (UON(4) && u < 48) { attn_sample_item<false>(p, lds, l, u - 24); }
                else if (UON(5) && u < 80) { gla_o_unit<true>(p, lds, l, u - 48, 0); }
                else if (UON(0) && u < 464) { const int v = u - 80; const int qb = 31 - v / 12, bh = v % 12; attn_unit<0>(p, lds, l, bh / 6, bh % 6, qb); }
                else if (UON(1) && u < 720) { const int v = u - 464; gla_o_unit<false>(p, lds, l, v >> 7, v & 127); }
                else if (UON(2)) { const int v = u - 720; const int qb = 31 - v / 12, bh = v % 12; attn_unit<1>(p, lds, l, bh / 6, bh % 6, qb); }
            }
            }
        }
        else if (k == 5 || k == 8) {
            if (ON(5) || ON(8)) {
            const bf16* A = (k == 5) ? (const bf16*)(ws + WS_XN) : (const bf16*)(ws + WS_H); const bf16* W = (k == 5) ? (const bf16*)(ws + wofs + WS_WO) : (const bf16*)(ws + wofs + WS_WDN);
            const int K = (k == 5) ? 1024 : DFF;
            {
                pg8::Gemm g{A, W, MP, 1024, K, K}; pg8::StaticOrder S; S.init(MP, 1024, gridDim.x, blockIdx.x);
                pg8::EpiResidual E{(k == 5 && l == 0) ? p.in[I_XP] : (const float*)p.out, p.out, DM};
                pg8::gemm_phase<pg8::EpiResidual, pg8::StaticOrder, true, true>(lds, g, S, E); }
            {
                const int nS = (k == 5) ? 8 : 16;
                pg8::Gemm g{A + (size_t)MP * K, W, MS, 1024, K / nS, K}; pg8::SplitOrder S; S.init(MS, 1024, nS, gridDim.x, blockIdx.x);
                pg8::EpiPartial E{(float*)(ws + WS_PART), DM, (size_t)MS * DM};
                pg8::gemm_phase<pg8::EpiPartial, pg8::SplitOrder, false, false>(lds, g, S, E); }
            }
        }
        else if (k == 6) { if (ON(6)) phase_rms(p, p.in[I_NORM2] + l * DM, false, rep > 0 ? 0 : 8, lds); }
        else {
            if (ON(7)) {
            pg8::Gemm g{(const bf16*)(ws + WS_XN), (const bf16*)(ws + wofs + WS_WUP), MT, DFF, 1024}; pg8::StaticOrder S; S.init(MT, DFF, gridDim.x, blockIdx.x);
            pg8::EpiStore<1> E{(bf16*)(ws + WS_H), DFF, DFF, MT};
            pg8::gemm_phase<pg8::EpiStore<1>, pg8::StaticOrder, true, true>(lds, g, S, E);
            if (l == 0) { if (gridDim.x > 64) phase_weights(p, 1, lds, 32, gridDim.x - 32); else phase_weights(p, 1, lds, 0, gridDim.x); }
            }
        }
        }
        if (ph + 1 < ph_hi) { if (ph_lo < 0) grid.sync(); else GRID_BAR(); }
#ifdef EXTRA_SYNCS
        for (int q = 0; q < EXTRA_SYNCS; ++q) GRID_BAR();
#endif
    }
}
constexpr int N_PHASES = 19;

#ifndef N_LAUNCH_SPLIT
#define N_LAUNCH_SPLIT 0
#endif
extern "C" void kernel_launch(void* const* d_in, const int* in_sizes, int n_in, void* d_out, int out_size, void* d_ws, size_t ws_size, hipStream_t stream) {
    static int grid = 0;
    if (grid == 0) {
        if (n_in != 22 || out_size != (int)O_END || ws_size < WS_NEED) { fprintf(stderr, "kernel_launch: unexpected shapes (n_in %d out %d ws %zu need %zu)\n", n_in, out_size, ws_size, (size_t)WS_NEED); grid = -1; return; }
        int dev = 0, cus = 0, per_cu = 0;
        hipGetDevice(&dev); hipDeviceGetAttribute(&cus, hipDeviceAttributeMultiprocessorCount, dev);
        hipFuncSetAttribute((const void*)mega_fwd, hipFuncAttributeMaxDynamicSharedMemorySize, LDS_BYTES);
        hipOccupancyMaxActiveBlocksPerMultiprocessor(&per_cu, (const void*)mega_fwd, 512, LDS_BYTES);
        if (per_cu < 1) { fprintf(stderr, "kernel_launch: occupancy query says %d blocks per CU\n", per_cu); per_cu = 1; }
        (void)hipGetLastError();
        grid = cus;
    }
    if (grid < 0) return;
    hipMemsetAsync((char*)d_ws + WS_CTL, 0, 32768, stream);
    Params prm{};
    for (int i = 0; i < 22; ++i) prm.in[i] = (const float*)d_in[i];
    prm.out = (float*)d_out; prm.ws = (unsigned char*)d_ws;
#if N_LAUNCH_SPLIT
    for (int i = 0; i < N_PHASES; ++i) { prm.ph_lo = i; prm.ph_hi = i + 1; void* args[] = {&prm};
        hipLaunchCooperativeKernel((const void*)mega_fwd, dim3(grid), dim3(512), args, LDS_BYTES, stream); }
#else
    prm.ph_lo = 0; prm.ph_hi = N_PHASES; void* args[] = {&prm};
    hipError_t e = hipLaunchCooperativeKernel((const void*)mega_fwd, dim3(grid), dim3(512), args, LDS_BYTES, stream);
    if (e != hipSuccess) fprintf(stderr, "cooperative launch failed: %s (grid %d)\n", hipGetErrorString(e), grid);
#endif
}
```
